# Optimizing an MI355X kernel written in HIP

```python
import jax, jax.numpy as jnp
from jax import lax
import numpy as np


D_MODEL = 1024
BATCH = 4
SEQ = 4096
DEPTH = 2
DEC_BATCH = 8
DEC_SEQ = 64
PAST_LEN = 1024

CHUNK = 64
Q_BLOCK = 128
MIX_WIDTH = D_MODEL
GLA_WIDTH = MIX_WIDTH // 2
GLA_HEADS = 4
GLA_DV = GLA_WIDTH // GLA_HEADS
GLA_DK = GLA_DV // 2
GLA_KEY = GLA_HEADS * GLA_DK
GATE_RANK = 16
GATE_NORM = 16.0
SB_WIDTH = MIX_WIDTH - GLA_WIDTH
SB_HEADS = 8
SB_HD = SB_WIDTH // SB_HEADS
D_FF = 4 * D_MODEL
EPS = 1e-6
SPLITS = (GLA_KEY, GLA_KEY, GLA_WIDTH, GLA_WIDTH, GATE_RANK, SB_WIDTH, SB_WIDTH, SB_WIDTH)
IN_COLS = sum(SPLITS)
SPLIT_IDX = [int(i) for i in np.cumsum(SPLITS)[:-1]]

kernel_name = 'gla_stickbreaking_hybrid_stream_step'


def rmsnorm(x, g):
    xf = x.astype(jnp.float32)
    return xf * lax.rsqrt(jnp.mean(xf * xf, axis=-1, keepdims=True) + EPS) * g.astype(jnp.float32)


def project(x, norm_g, w_in, w_a2, b_a2, q_g, k_g):
    B, T = x.shape[0], x.shape[1]
    xn = rmsnorm(x, norm_g).astype(x.dtype)
    proj = (xn @ w_in).astype(jnp.float32)
    gq, gk, gv, gate, alr, sq, sk, sv = jnp.split(proj, SPLIT_IDX, axis=-1)
    log_a = jax.nn.log_sigmoid(alr @ w_a2.astype(jnp.float32) + b_a2.astype(jnp.float32)) / GATE_NORM

    def heads(t, h):
        return t.reshape(B, T, h, -1).transpose(0, 2, 1, 3)

    gla = (heads(gq, GLA_HEADS) * GLA_DK ** -0.5, heads(gk, GLA_HEADS), heads(gv, GLA_HEADS), heads(log_a, GLA_HEADS))
    sb = (rmsnorm(sq.reshape(B, T, SB_HEADS, SB_HD), q_g),
          rmsnorm(sk.reshape(B, T, SB_HEADS, SB_HD), k_g),
          sv.reshape(B, T, SB_HEADS, SB_HD))
    return gla, sb, gate


def gla_chunk(S, inp):
    q, k, v, la = inp
    L = q.shape[2]
    b = jnp.cumsum(la, axis=2)
    causal = jnp.tril(jnp.ones((L, L), dtype=bool))
    diff = b[:, :, :, None, :] - b[:, :, None, :, :]
    decay = jnp.exp(jnp.where(causal[None, None, :, :, None], diff, -jnp.inf))
    scores = jnp.einsum('bhtd,bhsd,bhtsd->bhts', q, k, decay)
    o = jnp.einsum('bhts,bhsv->bhtv', scores, v) + jnp.einsum('bhtd,bhdv->bhtv', q * jnp.exp(b), S)
    b_end = b[:, :, -1:, :]
    S_new = jnp.exp(b_end[:, :, 0, :])[..., None] * S + jnp.einsum('bhsd,bhsv->bhdv', k * jnp.exp(b_end - b), v)
    return S_new, o


def gla_prompt(q, k, v, la):
    B, H, T, _ = q.shape
    n = T // CHUNK

    def chunks(t):
        return jnp.moveaxis(t.reshape(B, H, n, CHUNK, t.shape[-1]), 2, 0)

    S0 = jnp.zeros((B, H, GLA_DK, GLA_DV), jnp.float32)
    S, o = lax.scan(gla_chunk, S0, (chunks(q), chunks(k), chunks(v), chunks(la)))
    o = jnp.moveaxis(o, 0, 2).reshape(B, H, T, GLA_DV)
    return S, o


def sb_block(q, q_pos, k, v, k_pos):
    z = jnp.einsum('bqhd,bkhd->bhqk', q, k) * SB_HD ** -0.5
    mask = (k_pos[None, :] < q_pos[:, None])[None, None]
    log_beta = jax.nn.log_sigmoid(z)
    l = jnp.where(mask, jax.nn.log_sigmoid(-z), 0.0)
    c = lax.cumsum(l, axis=3, reverse=True) - l
    w = jnp.where(mask, jnp.exp(log_beta + c), 0.0)
    return jnp.einsum('bhqk,bkhd->bqhd', w, v)


def sb_prompt(q, k, v):
    B, T, H, d = q.shape
    nb = T // Q_BLOCK
    pos = jnp.arange(T)
    qb = jnp.moveaxis(q.reshape(B, nb, Q_BLOCK, H, d), 1, 0)
    starts = jnp.arange(nb) * Q_BLOCK
    out = lax.map(lambda a: sb_block(a[0], a[1] + jnp.arange(Q_BLOCK), k, v, pos), (qb, starts))
    return jnp.moveaxis(out, 0, 1).reshape(B, T, H, d)


def finish(x, o_gla, gate, o_sb, gla_norm_g, w_out, norm2_g, w_up, w_down):
    B, T = x.shape[0], x.shape[1]
    og = rmsnorm(o_gla, gla_norm_g).transpose(0, 2, 1, 3).reshape(B, T, GLA_WIDTH) * jax.nn.silu(gate)
    mix = jnp.concatenate([og, o_sb.reshape(B, T, SB_WIDTH)], axis=-1).astype(x.dtype)
    h = x + mix @ w_out
    u = rmsnorm(h, norm2_g).astype(x.dtype) @ w_up
    return h + jnp.square(jax.nn.relu(u)) @ w_down


def setup_inputs(seed: int = 0) -> dict:
    key = jax.random.key(seed)
    ks = jax.random.split(key, 20)
    f32 = jnp.float32
    nrm = lambda k, s, sc: jax.random.normal(k, s, f32) * sc
    return {
        'x_prompt': nrm(ks[0], (BATCH, SEQ, D_MODEL), 1.0),
        'x_sample': nrm(ks[1], (DEC_BATCH, DEC_SEQ, D_MODEL), 1.0),
        'cache_sb_k': nrm(ks[2], (DEPTH, DEC_BATCH, PAST_LEN, SB_HEADS, SB_HD), 1.0),
        'cache_sb_v': nrm(ks[3], (DEPTH, DEC_BATCH, PAST_LEN, SB_HEADS, SB_HD), 1.0),
        'state_gla': nrm(ks[4], (DEPTH, DEC_BATCH, GLA_HEADS, GLA_DK, GLA_DV), 0.5),
        'norm1_g': 1.0 + nrm(ks[5], (DEPTH, D_MODEL), 0.02),
        'w_in': nrm(ks[6], (DEPTH, D_MODEL, IN_COLS), D_MODEL ** -0.5),
        'w_a2': nrm(ks[7], (DEPTH, GATE_RANK, GLA_KEY), GATE_RANK ** -0.5),
        'b_a2': nrm(ks[8], (DEPTH, GLA_KEY), 0.1),
        'q_norm_g': 1.0 + nrm(ks[9], (DEPTH, SB_HD), 0.02),
        'k_norm_g': 1.0 + nrm(ks[10], (DEPTH, SB_HD), 0.02),
        'gla_norm_g': 1.0 + nrm(ks[11], (DEPTH, GLA_DV), 0.02),
        'w_out': nrm(ks[12], (DEPTH, MIX_WIDTH, D_MODEL), MIX_WIDTH ** -0.5),
        'norm2_g': 1.0 + nrm(ks[13], (DEPTH, D_MODEL), 0.02),
        'w_up': nrm(ks[14], (DEPTH, D_MODEL, D_FF), D_MODEL ** -0.5),
        'w_down': nrm(ks[15], (DEPTH, D_FF, D_MODEL), D_FF ** -0.5),
    }


def reference(x_prompt, x_sample, cache_sb_k, cache_sb_v, state_gla, norm1_g, w_in, w_a2, b_a2,
              q_norm_g, k_norm_g, gla_norm_g, w_out, norm2_g, w_up, w_down):
    dt = x_prompt.dtype
    xp, xs = x_prompt, x_sample
    kp_l, vp_l, sp_l, ks_l, vs_l, ss_l = [], [], [], [], [], []
    P = cache_sb_k.shape[2]
    for l in range(DEPTH):
        lw = (norm1_g[l], w_in[l], w_a2[l], b_a2[l], q_norm_g[l], k_norm_g[l])
        tail = (gla_norm_g[l], w_out[l], norm2_g[l], w_up[l], w_down[l])
        gla_in, (sq, sk, sv), gate = project(xp, *lw)
        S_p, o_g = gla_prompt(*gla_in)
        o_s = sb_prompt(sq, sk, sv)
        xp = finish(xp, o_g, gate, o_s, *tail)
        kp_l.append(sk.astype(dt))
        vp_l.append(sv.astype(dt))
        sp_l.append(S_p.astype(dt))
        T = xs.shape[1]
        gla_in, (sq, sk, sv), gate = project(xs, *lw)
        S_s, o_g = gla_chunk(state_gla[l].astype(jnp.float32), gla_in)
        k_all = jnp.concatenate([cache_sb_k[l].astype(jnp.float32), sk], axis=1)
        v_all = jnp.concatenate([cache_sb_v[l].astype(jnp.float32), sv], axis=1)
        o_s = sb_block(sq, P + jnp.arange(T), k_all, v_all, jnp.arange(P + T))
        xs = finish(xs, o_g, gate, o_s, *tail)
        ks_l.append(sk.astype(dt))
        vs_l.append(sv.astype(dt))
        ss_l.append(S_s.astype(dt))
    return (xp, xs, jnp.stack(kp_l), jnp.stack(vp_l), jnp.stack(sp_l), jnp.stack(ks_l), jnp.stack(vs_l), jnp.stack(ss_l))
```

```cpp
#include <hip/hip_runtime.h>
#include <hip/hip_cooperative_groups.h>
#include <cstdio>
#include <cstdint>
namespace cg = cooperative_groups;

#define LAS __attribute__((address_space(3)))
typedef unsigned short bf16_t;
typedef short bf16x8 __attribute__((ext_vector_type(8)));
typedef short s16x4 __attribute__((ext_vector_type(4)));
typedef float f32x4 __attribute__((ext_vector_type(4)));
typedef float f32x2 __attribute__((ext_vector_type(2)));
typedef float f32x16 __attribute__((ext_vector_type(16)));
typedef unsigned u32x4 __attribute__((ext_vector_type(4)));
typedef unsigned u32x2 __attribute__((ext_vector_type(2)));
typedef __bf16 bf16x2_t __attribute__((ext_vector_type(2)));
typedef short v4i16_t __attribute__((ext_vector_type(4)));

constexpr int MP = 16384, MS = 512, M = MP + MS;
constexpr int D = 1024, FF = 4096, NIN = 3072, NINP = 3104;
constexpr float EPS = 1e-6f;
constexpr float LOG2E = 1.4426950408889634f;
constexpr float QSCALE = 0.125f * LOG2E;

constexpr size_t MiB = 1u << 20;
constexpr size_t WS_SSQ = 1 * MiB;
constexpr size_t WS_DEC = 1 * MiB + 512 * 1024;
constexpr size_t WS_ALRP = 2 * MiB;
constexpr size_t WS_WIN = 7 * MiB;
constexpr size_t WS_WOUT = 20 * MiB;
constexpr size_t WS_WUP = 24 * MiB;
constexpr size_t WS_WDN = 40 * MiB;
constexpr size_t WS_AB = 56 * MiB;
constexpr size_t WS_MIX = 89 * MiB;
constexpr size_t WS_U = 122 * MiB;
constexpr size_t WS_GQ = WS_U;
constexpr size_t WS_GK = WS_GQ + (size_t)M * 256 * 2;
constexpr size_t WS_GV = WS_GK + (size_t)M * 256 * 2;
constexpr size_t WS_GATE = WS_GV + (size_t)M * 512 * 2;
constexpr size_t WS_SQ = WS_GATE + (size_t)M * 512 * 2;
constexpr size_t WS_KB = WS_SQ + (size_t)M * 512 * 2;
constexpr size_t WS_VB = WS_KB + (size_t)M * 512 * 2;
constexpr size_t WS_UST = WS_VB + (size_t)M * 512 * 2;
constexpr size_t WS_END = WS_U + (size_t)M * FF * 2;
static_assert(WS_UST + (size_t)1056 * 8192 * 4 <= WS_END, "overlay");
static_assert(WS_END <= 256 * MiB, "ws");

constexpr size_t O_Y = 0;
constexpr size_t O_KP = (size_t)M * D;
constexpr size_t O_VP = O_KP + (size_t)2 * MP * 512;
constexpr size_t O_GP = O_VP + (size_t)2 * MP * 512;
constexpr size_t O_KS = O_GP + (size_t)2 * 16 * 8192;
constexpr size_t O_VS = O_KS + (size_t)2 * MS * 512;
constexpr size_t O_GS = O_VS + (size_t)2 * MS * 512;
constexpr size_t O_END = O_GS + (size_t)2 * 32 * 8192;

constexpr int LDS_BYTES = 147456;
#ifndef REP_GEMM
#define REP_GEMM 1
#endif
#ifndef REP_MIX
#define REP_MIX 1
#endif
#ifndef REP_PRO
#define REP_PRO 1
#endif
#ifndef REP_SMALL
#define REP_SMALL 1
#endif

struct Args { const float* in[16]; float* out; unsigned char* ws; };

__device__ __forceinline__ unsigned cvtpk(float lo, float hi) { f32x2 v = {lo, hi}; bf16x2_t b = __builtin_convertvector(v, bf16x2_t); return __builtin_bit_cast(unsigned, b); }
__device__ __forceinline__ unsigned f2bf(float f) { unsigned u = __builtin_bit_cast(unsigned, f); return (u + 0x7fffu + ((u >> 16) & 1u)) >> 16; }
__device__ __forceinline__ float bflo(unsigned w) { return __builtin_bit_cast(float, w << 16); }
__device__ __forceinline__ float bfhi(unsigned w) { return __builtin_bit_cast(float, w & 0xffff0000u); }
__device__ __forceinline__ int crow(int r, int hi) { return (r & 3) + 8 * (r >> 2) + 4 * hi; }
__device__ __forceinline__ float wave_sum(float v) {
#pragma unroll
    for (int o = 1; o < 64; o <<= 1) v += __shfl_xor(v, o);
    return v;
}
__device__ __forceinline__ bf16x8 pack8f(const f32x4 a, const f32x4 b) { u32x4 w; w.x = cvtpk(a[0], a[1]); w.y = cvtpk(a[2], a[3]); w.z = cvtpk(b[0], b[1]); w.w = cvtpk(b[2], b[3]); return __builtin_bit_cast(bf16x8, w); }
__device__ __forceinline__ void lds_barrier() { asm volatile("s_waitcnt lgkmcnt(0)\n\ts_barrier" ::: "memory"); }
#define MFMA32(a, b, c) __builtin_amdgcn_mfma_f32_32x32x16_bf16((a), (b), (c), 0, 0, 0)

namespace pg8 {
constexpr int BM = 256, BK = 64, HALF = 128, HTB = HALF * BK * 2, STAGE_BYTES = 8 * HTB, NXCD = 8, WGM = 8;
__host__ __device__ __forceinline__ int lds_byte(int r, int c) { const int st = (r >> 4) * 2 + (c >> 5), rr = r & 15, cc = c & 31, ob = rr * 64 + cc * 2; return st * 1024 + (ob ^ (((ob >> 9) & 1) << 5)); }
__host__ __device__ __forceinline__ void stage_rc(int b, int& R, int& C) { const int st = b / 1024, sb = b % 1024, swz = sb ^ (((sb >> 9) & 1) << 5); R = (st >> 1) * 16 + swz / 64; C = (st & 1) * 32 + (swz % 64) / 2; }
__host__ __device__ __forceinline__ int perm32(int rho) { const int n = rho >> 4, i = rho & 15; return 8 * (i >> 2) + 4 * n + (i & 3); }
struct Unit { int pm, pn; };
struct Gemm { const bf16_t* A; const bf16_t* Bt; int M, N, K; };
struct StaticOrder {
    int nM, nN, nwg, G, c;
    __host__ __device__ void init(int M_, int N_, int G_, int c_) { nM = M_ / BM; nN = N_ / BM; nwg = nM * nN; G = G_; c = c_; }
    __host__ __device__ bool next(int i, Unit& u) const {
        const long Lx = (long)i * G + c; if (Lx >= nwg) return false;
        int wgid = (int)Lx; { const int q = nwg / NXCD, r = nwg % NXCD, xcd = wgid % NXCD, off = wgid / NXCD; wgid = (xcd < r ? xcd * (q + 1) : r * (q + 1) + (xcd - r) * q) + off; }
        const int nig = WGM * nN, gid = wgid / nig, fm = gid * WGM, gsz = (nM - fm) < WGM ? (nM - fm) : WGM;
        u.pm = fm + ((wgid % nig) % gsz); u.pn = (wgid % nig) / gsz; return true;
    }
    __device__ __forceinline__ void a_ready(const Unit&) const {}
    __device__ __forceinline__ void done(const Unit&) const {}
};

template <class Epi, class Sched, bool ALIGN_EPI = false, bool SP2 = false>
__device__ __forceinline__ void gemm_phase(LAS unsigned char* lds, const Gemm g, const Sched& S, const Epi& E, const int tid) {
    const int wid = __builtin_amdgcn_readfirstlane(tid >> 6), lane = tid & 63, wr = wid >> 2, wc = wid & 3, fr = lane & 15, fq = lane >> 4;
    const int K = g.K, nt = K / BK;
    unsigned voffA[2], voffB[2];
#pragma unroll
    for (int i = 0; i < 2; ++i) { int R, C; stage_rc(tid * 16 + i * 8192, R, C); const int Rb = Epi::PERM ? ((R & ~31) + perm32(R & 31)) : R;
        voffA[i] = (unsigned)(R * K + C) * 2u; voffB[i] = (unsigned)(Rb * K + C) * 2u; }
    const size_t kstep = (size_t)(BK * 2);
    const size_t hstep = (size_t)HALF * K * 2;
    const size_t tstep = 2 * hstep;
    const unsigned ldsw = (unsigned)wid * 1024u;
    const int aoff = lds_byte(wr * 64 + fr, fq * 8), boff = lds_byte(wc * 32 + fr, fq * 8);
#define PG8_SA(b, h) (((b) * 2 + (h)) * HTB)
#define PG8_SB(b, h) ((4 + (b) * 2 + (h)) * HTB)
#define PG8_STAGE(bufoff, gbase, voff) do { _Pragma("unroll") for (int _i = 0; _i < 2; ++_i) \
        __builtin_amdgcn_global_load_lds((const unsigned*)((const char*)(gbase) + (voff)[_i]), (LAS unsigned*)(lds + (bufoff) + ldsw + _i * 8192), 16, 0, 0); } while (0)
#define PG8_LDA(dst, b, h) do { _Pragma("unroll") for (int m = 0; m < 4; ++m) _Pragma("unroll") for (int k = 0; k < 2; ++k) dst[m][k] = *(const LAS bf16x8*)(lds + PG8_SA(b, h) + aoff + m * 2048 + k * 1024); } while (0)
#define PG8_LDB(dst, b, h) do { _Pragma("unroll") for (int n = 0; n < 2; ++n) _Pragma("unroll") for (int k = 0; k < 2; ++k) dst[n][k] = *(const LAS bf16x8*)(lds + PG8_SB(b, h) + boff + n * 2048 + k * 1024); } while (0)
#define PG8_MMA(ai, bj, At, Bt) do { __builtin_amdgcn_s_setprio(1); _Pragma("unroll") for (int m = 0; m < 4; ++m) _Pragma("unroll") for (int n = 0; n < 2; ++n) _Pragma("unroll") for (int k = 0; k < 2; ++k) \
        acc[ai][bj][m][n] = __builtin_amdgcn_mfma_f32_16x16x32_bf16(Bt[n][k], At[m][k], acc[ai][bj][m][n], 0, 0, 0); __builtin_amdgcn_s_setprio(0); } while (0)
#define PG8_WAIT_V(n) asm volatile("s_waitcnt vmcnt(" #n ")" ::: "memory")
#define PG8_WAIT_L(n) asm volatile("s_waitcnt lgkmcnt(" #n ")" ::: "memory")
#define PG8_BAR __builtin_amdgcn_s_barrier()
#define PG8_SCHED __builtin_amdgcn_sched_barrier(0)
    Unit cur, nxt; int ui = 0;
    if (!S.next(0, cur)) return;
    f32x4 acc[2][2][4][2];
#pragma unroll
    for (int a = 0; a < 2; ++a)
#pragma unroll
        for (int b = 0; b < 2; ++b)
#pragma unroll
            for (int m = 0; m < 4; ++m)
#pragma unroll
                for (int n = 0; n < 2; ++n) acc[a][b][m][n] = (f32x4){0.f, 0.f, 0.f, 0.f};
    bf16x8 At[4][2], B0[2][2], B1[2][2];
    const char* cA = (const char*)g.A + (size_t)cur.pm * tstep; const char* cB = (const char*)g.Bt + (size_t)cur.pn * tstep;
    S.a_ready(cur);
    if constexpr (SP2) {
        PG8_STAGE(PG8_SB(0, 0), cB, voffB); PG8_STAGE(PG8_SB(0, 1), cB + hstep, voffB); PG8_STAGE(PG8_SA(0, 0), cA, voffA); PG8_STAGE(PG8_SA(0, 1), cA + hstep, voffA);
        if (wr == 1) PG8_BAR;
        PG8_WAIT_V(2); PG8_BAR;
        PG8_STAGE(PG8_SB(1, 0), cB + kstep, voffB); PG8_STAGE(PG8_SA(1, 0), cA + kstep, voffA); PG8_STAGE(PG8_SB(1, 1), cB + hstep + kstep, voffB);
        PG8_WAIT_V(6); PG8_BAR;
    } else {
        PG8_STAGE(PG8_SB(0, 0), cB, voffB); PG8_STAGE(PG8_SA(0, 0), cA, voffA); PG8_STAGE(PG8_SB(0, 1), cB + hstep, voffB); PG8_STAGE(PG8_SA(0, 1), cA + hstep, voffA);
        if (wr == 1) PG8_BAR;
        PG8_WAIT_V(4); PG8_BAR;
        PG8_STAGE(PG8_SB(1, 0), cB + kstep, voffB); PG8_STAGE(PG8_SA(1, 0), cA + kstep, voffA); PG8_STAGE(PG8_SB(1, 1), cB + hstep + kstep, voffB);
        PG8_WAIT_V(6); PG8_BAR;
    }
    for (;;) {
        const bool has_next = S.next(ui + 1, nxt);
        const char* nA = has_next ? (const char*)g.A + (size_t)nxt.pm * tstep : cA; const char* nB = has_next ? (const char*)g.Bt + (size_t)nxt.pn * tstep : cB;
        for (int t = 0; t < nt; t += 2) {
            const bool last = (t == nt - 2);
            const char* a1 = cA + (size_t)(t + 1) * kstep;
            const char* a2 = last ? nA : cA + (size_t)(t + 2) * kstep; const char* b2 = last ? nB : cB + (size_t)(t + 2) * kstep;
            const char* a3 = a2 + kstep; const char* b3 = b2 + kstep;
            if (last && has_next) S.a_ready(nxt);
            if constexpr (SP2) {
            PG8_LDB(B0, 0, 0); PG8_LDB(B1, 0, 1); PG8_SCHED; PG8_LDA(At, 0, 0); PG8_STAGE(PG8_SA(1, 1), a1 + hstep, voffA);
            PG8_WAIT_V(8); PG8_WAIT_L(0); PG8_BAR; PG8_MMA(0, 0, At, B0); PG8_MMA(0, 1, At, B1); PG8_BAR; PG8_SCHED;
            PG8_LDA(At, 0, 1); PG8_STAGE(PG8_SB(0, 0), b2, voffB); PG8_STAGE(PG8_SB(0, 1), b2 + hstep, voffB); PG8_STAGE(PG8_SA(0, 0), a2, voffA);
            PG8_WAIT_V(8); PG8_WAIT_L(0); PG8_BAR; PG8_MMA(1, 0, At, B0); PG8_MMA(1, 1, At, B1); PG8_BAR; PG8_SCHED;
            PG8_LDB(B0, 1, 0); PG8_LDB(B1, 1, 1); PG8_SCHED; PG8_LDA(At, 1, 0); PG8_STAGE(PG8_SA(0, 1), a2 + hstep, voffA);
            PG8_WAIT_V(8); PG8_WAIT_L(0); PG8_BAR; PG8_MMA(0, 0, At, B0); PG8_MMA(0, 1, At, B1); PG8_BAR; PG8_SCHED;
            PG8_LDA(At, 1, 1); PG8_STAGE(PG8_SB(1, 0), b3, voffB); PG8_STAGE(PG8_SB(1, 1), b3 + hstep, voffB); PG8_STAGE(PG8_SA(1, 0), a3, voffA);
            PG8_WAIT_V(8); PG8_WAIT_L(0); PG8_BAR; PG8_MMA(1, 0, At, B0); PG8_MMA(1, 1, At, B1); PG8_BAR; PG8_SCHED;
            } else {
            PG8_LDB(B0, 0, 0); PG8_SCHED; PG8_LDA(At, 0, 0); PG8_STAGE(PG8_SA(1, 1), a1 + hstep, voffA);
            PG8_WAIT_L(8); PG8_BAR; PG8_WAIT_L(0); PG8_MMA(0, 0, At, B0); PG8_BAR; PG8_SCHED;
            PG8_LDB(B1, 0, 1); PG8_STAGE(PG8_SB(0, 0), b2, voffB);
            PG8_BAR; PG8_WAIT_L(0); PG8_MMA(0, 1, At, B1); PG8_BAR;
            PG8_LDA(At, 0, 1); PG8_STAGE(PG8_SA(0, 0), a2, voffA);
            PG8_BAR; PG8_WAIT_L(0); PG8_MMA(1, 0, At, B0); PG8_BAR; PG8_SCHED;
            PG8_STAGE(PG8_SB(0, 1), b2 + hstep, voffB);
            PG8_WAIT_V(6); PG8_BAR; PG8_MMA(1, 1, At, B1); PG8_BAR;
            PG8_LDB(B0, 1, 0); PG8_SCHED; PG8_LDA(At, 1, 0); PG8_STAGE(PG8_SA(0, 1), a2 + hstep, voffA);
            PG8_WAIT_L(8); PG8_BAR; PG8_WAIT_L(0); PG8_MMA(0, 0, At, B0); PG8_BAR; PG8_SCHED;
            PG8_LDB(B1, 1, 1); PG8_STAGE(PG8_SB(1, 0), b3, voffB);
            PG8_BAR; PG8_WAIT_L(0); PG8_MMA(0, 1, At, B1); PG8_BAR;
            PG8_LDA(At, 1, 1); PG8_STAGE(PG8_SA(1, 0), a3, voffA);
            PG8_BAR; PG8_WAIT_L(0); PG8_MMA(1, 0, At, B0); PG8_BAR; PG8_SCHED;
            PG8_STAGE(PG8_SB(1, 1), b3 + hstep, voffB);
            PG8_WAIT_V(6); PG8_BAR; PG8_MMA(1, 1, At, B1); PG8_BAR;
            }
        }
        if constexpr (ALIGN_EPI) { if (wr == 0) PG8_BAR; }
        E(acc, cur, wr, wc, fr, fq); S.done(cur);
        if (!has_next) break;
#pragma unroll
        for (int a = 0; a < 2; ++a)
#pragma unroll
            for (int b = 0; b < 2; ++b)
#pragma unroll
                for (int m = 0; m < 4; ++m)
#pragma unroll
                    for (int n = 0; n < 2; ++n) acc[a][b][m][n] = (f32x4){0.f, 0.f, 0.f, 0.f};
        cur = nxt; cA = nA; cB = nB; ++ui;
        if constexpr (ALIGN_EPI) { if (wr == 1) PG8_BAR; }
    }
    PG8_WAIT_V(0);
    if constexpr (!ALIGN_EPI) { if (wr == 0) PG8_BAR; }
    PG8_BAR;
#undef PG8_SA
#undef PG8_SB
#undef PG8_STAGE
#undef PG8_LDA
#undef PG8_LDB
#undef PG8_MMA
#undef PG8_WAIT_V
#undef PG8_WAIT_L
#undef PG8_BAR
#undef PG8_SCHED
}


struct EpiIn {
    static constexpr bool PERM = true;
    const float* ssq; bf16_t *GQ, *GK, *GV, *GATE, *SQ, *KB, *VB; float *Kp, *Vp, *Ks, *Vs; const float *qg, *kg;
    __device__ __forceinline__ void operator()(const f32x4 (&acc)[2][2][4][2], const Unit& u, int wr, int wc, int fr, int fq) const {
        const int pn = u.pn;
        float sv[2][4];
#pragma unroll
        for (int ai = 0; ai < 2; ++ai)
#pragma unroll
            for (int m = 0; m < 4; ++m) sv[ai][m] = ssq[u.pm * BM + ai * HALF + wr * 64 + m * 16 + fr];
        f32x4 gg[2][2];
        { const float* gp0 = (pn < 8) ? qg : kg;
#pragma unroll
          for (int bj = 0; bj < 2; ++bj) { gg[bj][0] = *(const f32x4*)(gp0 + 32 * bj + 8 * fq); gg[bj][1] = *(const f32x4*)(gp0 + 32 * bj + 8 * fq + 4); } }
        __builtin_amdgcn_sched_barrier(0);
#pragma unroll
        for (int ai = 0; ai < 2; ++ai)
#pragma unroll
            for (int m = 0; m < 4; ++m) {
                const int row = u.pm * BM + ai * HALF + wr * 64 + m * 16 + fr;
                const float s = rsqrtf(sv[ai][m] * (1.0f / D) + EPS);
                f32x4 v[2][2];
#pragma unroll
                for (int bj = 0; bj < 2; ++bj)
#pragma unroll
                    for (int n = 0; n < 2; ++n) v[bj][n] = acc[ai][bj][m][n] * s;
                if (pn < 6) {
                    bf16_t* base; int pitch, c0; float sc = 1.f;
                    if (pn == 0) { base = GQ; pitch = 256; c0 = 0; sc = 0.125f; }
                    else if (pn == 1) { base = GK; pitch = 256; c0 = 0; }
                    else if (pn < 4) { base = GV; pitch = 512; c0 = (pn - 2) * 256; }
                    else { base = GATE; pitch = 512; c0 = (pn - 4) * 256; }
#pragma unroll
                    for (int bj = 0; bj < 2; ++bj) {
                        const f32x4 a = v[bj][0] * sc, b = v[bj][1] * sc;
                        u32x4 w; w.x = cvtpk(a[0], a[1]); w.y = cvtpk(a[2], a[3]); w.z = cvtpk(b[0], b[1]); w.w = cvtpk(b[2], b[3]);
                        *(u32x4*)(base + (size_t)row * pitch + c0 + bj * HALF + wc * 32 + 8 * fq) = w;
                    }
                } else if (pn < 10) {
                    float q = 0.f;
#pragma unroll
                    for (int bj = 0; bj < 2; ++bj)
#pragma unroll
                        for (int n = 0; n < 2; ++n) { const f32x4 x = v[bj][n]; q += (x[0] * x[0] + x[1] * x[1]) + (x[2] * x[2] + x[3] * x[3]); }
                    q += __shfl_xor(q, 16); q += __shfl_xor(q, 32);
                    const float rs = rsqrtf(q * (1.0f / 64.0f) + EPS);
                    const bool isq = pn < 8;
                    const float mul = isq ? rs * QSCALE : rs;
                    const size_t orow = (u.pm < 64) ? (size_t)row : (size_t)(row - MP);
                    float* kout = (u.pm < 64) ? Kp : Ks;
#pragma unroll
                    for (int bj = 0; bj < 2; ++bj) {
                        const int j = 32 * bj + 8 * fq;
                        const int col = (pn & 1) * 256 + 64 * wc + j;
                        const f32x4 g0 = gg[bj][0], g1 = gg[bj][1];
                        const f32x4 a = v[bj][0] * g0 * mul, b = v[bj][1] * g1 * mul;
                        u32x4 w; w.x = cvtpk(a[0], a[1]); w.y = cvtpk(a[2], a[3]); w.z = cvtpk(b[0], b[1]); w.w = cvtpk(b[2], b[3]);
                        if (isq) { *(u32x4*)(SQ + (size_t)row * 512 + col) = w; }
                        else { *(u32x4*)(KB + (size_t)row * 512 + col) = w; __builtin_nontemporal_store(a, (f32x4*)(kout + orow * 512 + col)); __builtin_nontemporal_store(b, (f32x4*)(kout + orow * 512 + col + 4)); }
                    }
                } else {
                    const size_t orow = (u.pm < 64) ? (size_t)row : (size_t)(row - MP);
                    float* vout = (u.pm < 64) ? Vp : Vs;
#pragma unroll
                    for (int bj = 0; bj < 2; ++bj) {
                        const int col = (pn - 10) * 256 + bj * HALF + wc * 32 + 8 * fq;
                        const f32x4 a = v[bj][0], b = v[bj][1];
                        u32x4 w; w.x = cvtpk(a[0], a[1]); w.y = cvtpk(a[2], a[3]); w.z = cvtpk(b[0], b[1]); w.w = cvtpk(b[2], b[3]);
                        *(u32x4*)(VB + (size_t)row * 512 + col) = w; __builtin_nontemporal_store(a, (f32x4*)(vout + orow * 512 + col)); __builtin_nontemporal_store(b, (f32x4*)(vout + orow * 512 + col + 4));
                    }
                }
            }
    }
};

struct EpiRes {
    static constexpr bool PERM = true;
    const float* res_f; const bf16_t* res_b;
    float* out; bf16_t* outb; float* ssq;
    __device__ __forceinline__ void operator()(const f32x4 (&acc)[2][2][4][2], const Unit& u, int wr, int wc, int fr, int fq) const {
#pragma unroll
        for (int ai = 0; ai < 2; ++ai)
#pragma unroll
        for (int mp = 0; mp < 2; ++mp) {
            f32x4 rv[2][2][2];
            if (res_f) {
#pragma unroll
                for (int mm = 0; mm < 2; ++mm) {
                    const int row = u.pm * BM + ai * HALF + wr * 64 + (2 * mp + mm) * 16 + fr;
                    const float* rp = res_f + (size_t)row * D;
#pragma unroll
                    for (int bj = 0; bj < 2; ++bj) { const int col = u.pn * BM + bj * HALF + wc * 32 + 8 * fq; rv[mm][bj][0] = *(const f32x4*)(rp + col); rv[mm][bj][1] = *(const f32x4*)(rp + col + 4); }
                }
            } else {
                u32x4 rb[2][2];
#pragma unroll
                for (int mm = 0; mm < 2; ++mm) {
                    const int row = u.pm * BM + ai * HALF + wr * 64 + (2 * mp + mm) * 16 + fr;
#pragma unroll
                    for (int bj = 0; bj < 2; ++bj) rb[mm][bj] = *(const u32x4*)(res_b + (size_t)row * D + u.pn * BM + bj * HALF + wc * 32 + 8 * fq);
                }
                __builtin_amdgcn_sched_barrier(0);
#pragma unroll
                for (int mm = 0; mm < 2; ++mm)
#pragma unroll
                    for (int bj = 0; bj < 2; ++bj) { const u32x4 w = rb[mm][bj];
                        rv[mm][bj][0] = (f32x4){bflo(w.x), bfhi(w.x), bflo(w.y), bfhi(w.y)}; rv[mm][bj][1] = (f32x4){bflo(w.z), bfhi(w.z), bflo(w.w), bfhi(w.w)}; }
            }
            __builtin_amdgcn_sched_barrier(0);
#pragma unroll
            for (int mm = 0; mm < 2; ++mm) {
                const int m = 2 * mp + mm;
                const int row = u.pm * BM + ai * HALF + wr * 64 + m * 16 + fr;
                float q = 0.f;
#pragma unroll
                for (int bj = 0; bj < 2; ++bj) {
                    const int col = u.pn * BM + bj * HALF + wc * 32 + 8 * fq;
                    const f32x4 a = acc[ai][bj][m][0] + rv[mm][bj][0], b = acc[ai][bj][m][1] + rv[mm][bj][1];
                    if (out) { __builtin_nontemporal_store(a, (f32x4*)(out + (size_t)row * D + col)); __builtin_nontemporal_store(b, (f32x4*)(out + (size_t)row * D + col + 4)); }
                    if (outb) {
                        u32x4 w; w.x = cvtpk(a[0], a[1]); w.y = cvtpk(a[2], a[3]); w.z = cvtpk(b[0], b[1]); w.w = cvtpk(b[2], b[3]);
                        *(u32x4*)(outb + (size_t)row * D + col) = w;
                        q += (a[0] * a[0] + a[1] * a[1]) + (a[2] * a[2] + a[3] * a[3]) + (b[0] * b[0] + b[1] * b[1]) + (b[2] * b[2] + b[3] * b[3]);
                    }
                }
                if (outb) { q += __shfl_xor(q, 16); q += __shfl_xor(q, 32); if (fq == 0) atomicAdd(ssq + row, q); }
            }
            __builtin_amdgcn_sched_barrier(0);
        }
    }
};

struct EpiUp {
    static constexpr bool PERM = true;
    const float* ssq; bf16_t* U;
    __device__ __forceinline__ void operator()(const f32x4 (&acc)[2][2][4][2], const Unit& u, int wr, int wc, int fr, int fq) const {
        float sv[2][4];
#pragma unroll
        for (int ai = 0; ai < 2; ++ai)
#pragma unroll
            for (int m = 0; m < 4; ++m) sv[ai][m] = ssq[u.pm * BM + ai * HALF + wr * 64 + m * 16 + fr];
        __builtin_amdgcn_sched_barrier(0);
#pragma unroll
        for (int ai = 0; ai < 2; ++ai)
#pragma unroll
            for (int m = 0; m < 4; ++m) {
                const int row = u.pm * BM + ai * HALF + wr * 64 + m * 16 + fr;
                const float s = rsqrtf(sv[ai][m] * (1.0f / D) + EPS);
#pragma unroll
                for (int bj = 0; bj < 2; ++bj) {
                    const int col = u.pn * BM + bj * HALF + wc * 32 + 8 * fq;
                    f32x4 a = acc[ai][bj][m][0] * s, b = acc[ai][bj][m][1] * s;
#pragma unroll
                    for (int i = 0; i < 4; ++i) { const float x = fmaxf(a[i], 0.f), y = fmaxf(b[i], 0.f); a[i] = x * x; b[i] = y * y; }
                    u32x4 w; w.x = cvtpk(a[0], a[1]); w.y = cvtpk(a[2], a[3]); w.z = cvtpk(b[0], b[1]); w.w = cvtpk(b[2], b[3]);
                    *(u32x4*)(U + (size_t)row * FF + col) = w;
                }
            }
    }
};
}

__device__ __forceinline__ int win_src_col(int pb) {
    const int pn = pb >> 3, pc0 = (pb & 7) * 32;
    int logical = pc0;
    if (pn >= 6 && pn <= 9) { const int bj = pc0 >> 7, wc = (pc0 & 127) >> 5; logical = 64 * wc + 32 * bj; }
    const int Lc = 256 * pn + logical;
    return Lc < 1536 ? Lc : Lc + 16;
}
__device__ __forceinline__ void transpose_item(const float* W, int ldw, int src_col0, bool alr, int k0, bf16_t* WT, int K, int dst_row0, const float* g, LAS float* scr, int lane) {
    const int r8 = lane >> 3, c4 = lane & 7, coff = alr ? 4 * (c4 & 3) : 4 * c4;
    f32x4 wv[8]; float gv[8];
#pragma unroll
    for (int u = 0; u < 8; ++u) { const int kk = 8 * u + r8; wv[u] = __builtin_nontemporal_load((const f32x4*)(W + (size_t)(k0 + kk) * ldw + src_col0 + coff)); gv[u] = g ? g[k0 + kk] : 1.0f; }
    __builtin_amdgcn_sched_barrier(0);
#pragma unroll
    for (int u = 0; u < 8; ++u) { const int kk = 8 * u + r8; LAS float* d_ = scr + kk * 33 + 4 * c4;
        d_[0] = wv[u][0] * gv[u]; d_[1] = wv[u][1] * gv[u]; d_[2] = wv[u][2] * gv[u]; d_[3] = wv[u][3] * gv[u]; }
    asm volatile("s_waitcnt lgkmcnt(0)" ::: "memory");
    const int c = lane & 7;
#pragma unroll
    for (int j = 0; j < 4; ++j) { const int n = (lane >> 3) + 8 * j; const LAS float* s = scr + (8 * c) * 33 + n;
        u32x4 o; o.x = cvtpk(s[0 * 33], s[1 * 33]); o.y = cvtpk(s[2 * 33], s[3 * 33]); o.z = cvtpk(s[4 * 33], s[5 * 33]); o.w = cvtpk(s[6 * 33], s[7 * 33]);
        *(u32x4*)(WT + (size_t)(dst_row0 + n) * K + k0 + 8 * c) = o; }
    asm volatile("s_waitcnt lgkmcnt(0)" ::: "memory");
}

__device__ __forceinline__ void prologue(const Args& a, LAS unsigned char* L, int tid, int wave, int lane) {
    unsigned char* ws = a.ws;
    LAS float* scr = (LAS float*)(L + wave * 16384);
    const int gw = blockIdx.x * 8 + wave, NGW = gridDim.x * 8;
    constexpr int I_IN = 16 * 97, I_OUT = 16 * 32, I_UP = 16 * 128, I_DN = 64 * 32, I_L = I_IN + I_OUT + I_UP + I_DN;
    for (int it = gw; it < 2 * I_L; it += NGW) {
        const int l = it / I_L; int r = it % I_L;
        if (r < I_IN) { const int kb = r / 97, pb = r % 97; const bool alr = pb == 96;
            transpose_item(a.in[6] + (size_t)l * D * 3088, 3088, alr ? 1536 : win_src_col(pb), alr, 64 * kb, (bf16_t*)(ws + WS_WIN) + (size_t)l * NINP * D, D, 32 * pb, a.in[5] + l * D, scr, lane); continue; }
        r -= I_IN;
        if (r < I_OUT) { const int kb = r / 32, nb = r % 32;
            transpose_item(a.in[12] + (size_t)l * D * D, D, 32 * nb, false, 64 * kb, (bf16_t*)(ws + WS_WOUT) + (size_t)l * D * D, D, 32 * nb, nullptr, scr, lane); continue; }
        r -= I_OUT;
        if (r < I_UP) { const int kb = r / 128, nb = r % 128;
            transpose_item(a.in[14] + (size_t)l * D * FF, FF, 32 * nb, false, 64 * kb, (bf16_t*)(ws + WS_WUP) + (size_t)l * FF * D, D, 32 * nb, a.in[13] + l * D, scr, lane); continue; }
        r -= I_UP;
        { const int kb = r / 32, nb = r % 32;
            transpose_item(a.in[15] + (size_t)l * FF * D, D, 32 * nb, false, 64 * kb, (bf16_t*)(ws + WS_WDN) + (size_t)l * D * FF, FF, 32 * nb, nullptr, scr, lane); }
    }
    float* ssq = (float*)(ws + WS_SSQ);
    bf16_t* AB = (bf16_t*)(ws + WS_AB);
    for (int m0 = gw; m0 < M; m0 += 4 * NGW) {
        f32x4 v[4][4];
#pragma unroll
        for (int q = 0; q < 4; ++q) { const int m = m0 + q * NGW;
            if (m < M) { const float* xr = (m < MP) ? a.in[0] + (size_t)m * D : a.in[1] + (size_t)(m - MP) * D; const f32x4* x4 = (const f32x4*)xr + lane;
#pragma unroll
                for (int j = 0; j < 4; ++j) v[q][j] = __builtin_nontemporal_load(x4 + 64 * j); } }
        __builtin_amdgcn_sched_barrier(0);
#pragma unroll
        for (int q = 0; q < 4; ++q) { const int m = m0 + q * NGW;
            if (m < M) { float s = 0.f;
#pragma unroll
                for (int j = 0; j < 4; ++j) s += (v[q][j].x * v[q][j].x + v[q][j].y * v[q][j].y) + (v[q][j].z * v[q][j].z + v[q][j].w * v[q][j].w);
                s = wave_sum(s);
                u32x2* o8 = (u32x2*)(AB + (size_t)m * D) + lane;
#pragma unroll
                for (int j = 0; j < 4; ++j) { u32x2 w; w.x = cvtpk(v[q][j].x, v[q][j].y); w.y = cvtpk(v[q][j].z, v[q][j].w); o8[64 * j] = w; }
                if (lane == 0) ssq[m] = s; } }
    }
    for (int i = blockIdx.x * 512 + tid; i < 3 * M; i += gridDim.x * 512) ssq[M + i] = 0.f;
}

template <int KS, bool AF32, class EPI>
__device__ __forceinline__ void small_gemm(LAS unsigned char* L, const void* Abase, int K, const bf16_t* Bt, int ncg, const EPI& E, int tid, int nrb = 16) {
    const int lane = tid & 63, wave = __builtin_amdgcn_readfirstlane(tid >> 6), r32 = lane & 31, hi = lane >> 5;
    constexpr int GPW = 8 / KS;
    constexpr int PITCH = 144;
    const int grp = wave / KS, ks = wave % KS;
    const int ntasks = nrb * ncg, per_pass = gridDim.x * GPW, npass = (ntasks + per_pass - 1) / per_pass;
    LAS float* RED = (LAS float*)L; LAS float* SSP = (LAS float*)(L + 114688); LAS float* SSR = (LAS float*)(L + 114688 + 1024);
    LAS unsigned char* SA = L + wave * (3 * 32 * PITCH); LAS unsigned char* SB0 = SA + 32 * PITCH; LAS unsigned char* SB1 = SB0 + 32 * PITCH;
    for (int p = 0; p < npass; ++p) {
        const int task = (p * gridDim.x + blockIdx.x) * GPW + grp;
        const bool act = task < ntasks;
        f32x16 acc0, acc1;
#pragma unroll
        for (int i = 0; i < 16; ++i) { acc0[i] = 0.f; acc1[i] = 0.f; }
        float q8[8];
#pragma unroll
        for (int i = 0; i < 8; ++i) q8[i] = 0.f;
        int rb = 0, cg = 0;
        if (act) {
            rb = task / ncg; cg = task - rb * ncg;
            const int Kw = K / KS, nb = Kw / 64, k0 = ks * Kw;
            const bf16_t* b0p = Bt + (size_t)(E.brow(cg, 0) + (lane >> 3)) * K + k0 + 8 * (lane & 7);
            const bf16_t* b1p = Bt + (size_t)(E.brow(cg, 1) + (lane >> 3)) * K + k0 + 8 * (lane & 7);
            const float* afp = (const float*)Abase + (size_t)(32 * rb + (lane >> 4)) * K + k0 + 4 * (lane & 15);
            const bf16_t* abp = (const bf16_t*)Abase + (size_t)(32 * rb + (lane >> 3)) * K + k0 + 8 * (lane & 7);
            f32x4 xa[8]; u32x4 ab[4], bb0[4], bb1[4];
#define SG_LOAD(kb) do { \
                if constexpr (AF32) { _Pragma("unroll") for (int i = 0; i < 8; ++i) xa[i] = *(const f32x4*)(afp + (size_t)(4 * i) * K + 64 * (kb)); } \
                else { _Pragma("unroll") for (int i = 0; i < 4; ++i) ab[i] = *(const u32x4*)(abp + (size_t)(8 * i) * K + 64 * (kb)); } \
                _Pragma("unroll") for (int i = 0; i < 4; ++i) { bb0[i] = *(const u32x4*)(b0p + (size_t)(8 * i) * K + 64 * (kb)); bb1[i] = *(const u32x4*)(b1p + (size_t)(8 * i) * K + 64 * (kb)); } } while (0)
            SG_LOAD(0);
            for (int kb = 0; kb < nb; ++kb) {
                __builtin_amdgcn_sched_barrier(0);
                if constexpr (AF32) {
#pragma unroll
                    for (int i = 0; i < 8; ++i) { const f32x4 x = xa[i]; q8[i] += (x[0] * x[0] + x[1] * x[1]) + (x[2] * x[2] + x[3] * x[3]);
                        u32x2 w; w.x = cvtpk(x[0], x[1]); w.y = cvtpk(x[2], x[3]); *(LAS u32x2*)(SA + (4 * i + (lane >> 4)) * PITCH + 8 * (lane & 15)) = w; }
                } else {
#pragma unroll
                    for (int i = 0; i < 4; ++i) *(LAS u32x4*)(SA + (8 * i + (lane >> 3)) * PITCH + 16 * (lane & 7)) = ab[i];
                }
#pragma unroll
                for (int i = 0; i < 4; ++i) { *(LAS u32x4*)(SB0 + (8 * i + (lane >> 3)) * PITCH + 16 * (lane & 7)) = bb0[i]; *(LAS u32x4*)(SB1 + (8 * i + (lane >> 3)) * PITCH + 16 * (lane & 7)) = bb1[i]; }
                __builtin_amdgcn_sched_barrier(0);
                if (kb + 1 < nb) SG_LOAD(kb + 1);
                __builtin_amdgcn_sched_barrier(0);
#pragma unroll
                for (int j = 0; j < 4; ++j) {
                    const bf16x8 af = *(const LAS bf16x8*)(SA + r32 * PITCH + 32 * j + 16 * hi);
                    const bf16x8 f0 = *(const LAS bf16x8*)(SB0 + r32 * PITCH + 32 * j + 16 * hi), f1 = *(const LAS bf16x8*)(SB1 + r32 * PITCH + 32 * j + 16 * hi);
                    acc0 = MFMA32(af, f0, acc0); acc1 = MFMA32(af, f1, acc1);
                }
            }
#undef SG_LOAD
        }
        lds_barrier();
        if (ks != 0) {
#pragma unroll
            for (int i = 0; i < 16; ++i) { RED[(wave * 32 + i) * 64 + lane] = acc0[i]; RED[(wave * 32 + 16 + i) * 64 + lane] = acc1[i]; }
        }
        if (AF32) {
#pragma unroll
            for (int i = 0; i < 8; ++i) { float q = q8[i]; q += __shfl_xor(q, 1); q += __shfl_xor(q, 2); q += __shfl_xor(q, 4); q += __shfl_xor(q, 8);
                if ((lane & 15) == 0) SSP[wave * 32 + 4 * i + (lane >> 4)] = q; }
        }
        lds_barrier();
        if (ks == 0 && act) {
#pragma unroll
            for (int w2 = 1; w2 < KS; ++w2)
#pragma unroll
                for (int i = 0; i < 16; ++i) { acc0[i] += RED[((wave + w2) * 32 + i) * 64 + lane]; acc1[i] += RED[((wave + w2) * 32 + 16 + i) * 64 + lane]; }
            float ss[16];
            if (AF32) {
                float t = 0.f;
#pragma unroll
                for (int w2 = 0; w2 < KS; ++w2) t += SSP[(wave + w2) * 32 + r32];
                SSR[grp * 32 + r32] = t;
#pragma unroll
                for (int r = 0; r < 16; ++r) ss[r] = SSR[grp * 32 + crow(r, hi)];
            } else {
#pragma unroll
                for (int r = 0; r < 16; ++r) ss[r] = 0.f;
            }
            E(acc0, acc1, rb, cg, r32, hi, ss);
        }
        lds_barrier();
    }
}

struct SEpiIn {
    int l; unsigned char* ws; float* Ks; float* Vs; const float* qg; const float* kg;
    __device__ __forceinline__ int brow(int cg, int j) const {
        if (cg == 48) return NIN;
        const int pn = cg >> 2, hd = cg & 3;
        if (pn >= 6 && pn <= 9) return 256 * pn + 128 * j + 32 * hd;
        return 64 * cg + 32 * j;
    }
    __device__ __forceinline__ void operator()(const f32x16& acc0, const f32x16& acc1, int rb, int cg, int r32, int hi, const float (&ss)[16]) const {
        const int pn = cg >> 2, hd = cg & 3;
        if (cg == 48) {
            float* ALRP = (float*)(ws + WS_ALRP); float* ssq = (float*)(ws + WS_SSQ) + (size_t)(2 * l) * M;
#pragma unroll
            for (int r = 0; r < 16; ++r) { const int row = MP + 32 * rb + crow(r, hi);
                if (r32 < 16) ALRP[(size_t)row * 16 + r32] = acc0[r];
                if (r32 == 16) ssq[row] = ss[r]; }
            return;
        }
#pragma unroll
        for (int r = 0; r < 16; ++r) {
            const int rs_ = 32 * rb + crow(r, hi), row = MP + rs_;
            const float s = rsqrtf(ss[r] * (1.0f / D) + EPS);
            const float v0 = acc0[r] * s, v1 = acc1[r] * s;
            if (pn < 6) {
                bf16_t* base; int pitch, c0; float sc = 1.f;
                if (pn == 0) { base = (bf16_t*)(ws + WS_GQ); pitch = 256; c0 = 64 * cg; sc = 0.125f; }
                else if (pn == 1) { base = (bf16_t*)(ws + WS_GK); pitch = 256; c0 = 64 * (cg - 4); }
                else if (pn < 4) { base = (bf16_t*)(ws + WS_GV); pitch = 512; c0 = 64 * (cg - 8); }
                else { base = (bf16_t*)(ws + WS_GATE); pitch = 512; c0 = 64 * (cg - 16); }
                base[(size_t)row * pitch + c0 + r32] = (bf16_t)f2bf(v0 * sc); base[(size_t)row * pitch + c0 + 32 + r32] = (bf16_t)f2bf(v1 * sc);
            } else if (pn < 10) {
                float q = v0 * v0 + v1 * v1;
                q += __shfl_xor(q, 1); q += __shfl_xor(q, 2); q += __shfl_xor(q, 4); q += __shfl_xor(q, 8); q += __shfl_xor(q, 16);
                const float rn = rsqrtf(q * (1.0f / 64.0f) + EPS);
                const bool isq = pn < 8;
                const float* gp = isq ? qg : kg;
                const int col = ((pn & 1) * 4 + hd) * 64 + r32;
                const float a0 = v0 * rn * gp[r32], a1 = v1 * rn * gp[32 + r32];
                if (isq) { bf16_t* SQ = (bf16_t*)(ws + WS_SQ); SQ[(size_t)row * 512 + col] = (bf16_t)f2bf(a0 * QSCALE); SQ[(size_t)row * 512 + col + 32] = (bf16_t)f2bf(a1 * QSCALE); }
                else { bf16_t* KB = (bf16_t*)(ws + WS_KB); KB[(size_t)row * 512 + col] = (bf16_t)f2bf(a0); KB[(size_t)row * 512 + col + 32] = (bf16_t)f2bf(a1);
                    Ks[(size_t)rs_ * 512 + col] = a0; Ks[(size_t)rs_ * 512 + col + 32] = a1; }
            } else {
                const int col = 64 * (cg - 40) + r32; bf16_t* VB = (bf16_t*)(ws + WS_VB);
                VB[(size_t)row * 512 + col] = (bf16_t)f2bf(v0); VB[(size_t)row * 512 + col + 32] = (bf16_t)f2bf(v1);
                Vs[(size_t)rs_ * 512 + col] = v0; Vs[(size_t)rs_ * 512 + col + 32] = v1;
            }
        }
    }
};
struct SEpiAlr {
    float* ALRP;
    __device__ __forceinline__ int brow(int cg, int j) const { return NIN; }
    __device__ __forceinline__ void operator()(const f32x16& acc0, const f32x16& acc1, int rb, int cg, int r32, int hi, const float (&ss)[16]) const {
        if (r32 < 16) {
#pragma unroll
            for (int r = 0; r < 16; ++r) ALRP[(size_t)(32 * rb + crow(r, hi)) * 16 + r32] = acc0[r];
        }
    }
};
struct SEpiRes {
    const float* res; float* out;
    __device__ __forceinline__ int brow(int cg, int j) const { return 64 * cg + 32 * j; }
    __device__ __forceinline__ void operator()(const f32x16& acc0, const f32x16& acc1, int rb, int cg, int r32, int hi, const float (&ss)[16]) const {
#pragma unroll
        for (int r = 0; r < 16; ++r) { const size_t o = (size_t)(32 * rb + crow(r, hi)) * D + 64 * cg + r32;
            out[o] = res[o] + acc0[r]; out[o + 32] = res[o + 32] + acc1[r]; }
    }
};
struct SEpiUp {
    bf16_t* U;
    __device__ __forceinline__ int brow(int cg, int j) const { return 64 * cg + 32 * j; }
    __device__ __forceinline__ void operator()(const f32x16& acc0, const f32x16& acc1, int rb, int cg, int r32, int hi, const float (&ss)[16]) const {
#pragma unroll
        for (int r = 0; r < 16; ++r) { const size_t o = (size_t)(32 * rb + crow(r, hi)) * FF + 64 * cg + r32;
            const float s = rsqrtf(ss[r] * (1.0f / D) + EPS); const float x = fmaxf(acc0[r] * s, 0.f), y = fmaxf(acc1[r] * s, 0.f);
            U[o] = (bf16_t)f2bf(x * x); U[o + 32] = (bf16_t)f2bf(y * y); }
    }
};

__device__ __forceinline__ void alr_phase(const Args& a, int l, int wave, int lane) {
    const int r32 = lane & 31, hi = lane >> 5;
    const bf16_t* AB = (const bf16_t*)(a.ws + WS_AB);
    const bf16_t* Wt = (const bf16_t*)(a.ws + WS_WIN) + (size_t)l * NINP * D + (size_t)NIN * D;
    float* ALRP = (float*)(a.ws + WS_ALRP);
    const int NGW = gridDim.x * 8;
    for (int task = blockIdx.x * 8 + wave; task < 512 * 4; task += NGW) {
        const int rb = task >> 2, kq = task & 3;
        const bf16_t* ap = AB + (size_t)(32 * rb + r32) * D + 256 * kq + 8 * hi;
        const bf16_t* bp = Wt + (size_t)r32 * D + 256 * kq + 8 * hi;
        f32x16 acc;
#pragma unroll
        for (int i = 0; i < 16; ++i) acc[i] = 0.f;
#pragma unroll
        for (int kk = 0; kk < 16; ++kk) acc = MFMA32(*(const bf16x8*)(ap + 16 * kk), *(const bf16x8*)(bp + 16 * kk), acc);
        if (r32 < 16) {
#pragma unroll
            for (int r = 0; r < 16; ++r) ALRP[((size_t)kq * M + 32 * rb + crow(r, hi)) * 16 + r32] = acc[r];
        }
    }
}

__device__ __forceinline__ s16x4 vtr(const LAS unsigned char* p) { return __builtin_bit_cast(s16x4, __builtin_amdgcn_ds_read_tr16_b64_v4i16((LAS v4i16_t*)p)); }

template <bool MASK>
__device__ __forceinline__ void sb_ew(f32x16& p, float (&om)[16], int kbase, int qpos) {
#pragma unroll
    for (int r = 0; r < 16; ++r) {
        const float x = __builtin_fmaxf(p[r], -100.0f);
        const float e = __builtin_amdgcn_exp2f(-x), b = __builtin_amdgcn_rcpf(1.0f + e), o_ = e * b;
        if (MASK) { const bool ok = (kbase + (r & 3) + 8 * (r >> 2)) < qpos; om[r] = ok ? o_ : 1.0f; p[r] = ok ? b : 0.0f; }
        else { om[r] = o_; p[r] = b; }
    }
}
__device__ __forceinline__ void sb_cum(f32x16& p, const float (&om)[16], float& run, int hi) {
#pragma unroll
    for (int g = 3; g >= 0; --g) {
        const float Go = (om[4 * g] * om[4 * g + 1]) * (om[4 * g + 2] * om[4 * g + 3]); const float Gp = __shfl_xor(Go, 32);
        const float c3 = run * (hi == 0 ? Gp : 1.0f), c2 = c3 * om[4 * g + 3], c1 = c2 * om[4 * g + 2], c0 = c1 * om[4 * g + 1];
        p[4 * g + 3] *= c3; p[4 * g + 2] *= c2; p[4 * g + 1] *= c1; p[4 * g] *= c0;
        run *= Go * Gp;
    }
}

__device__ __forceinline__ void sb_unit(const Args& a, int l, int u, LAS unsigned char* wl, int lane) {
    const int r32 = lane & 31, hi = lane >> 5;
    const bf16_t* SQ = (const bf16_t*)(a.ws + WS_SQ); const bf16_t* KB = (const bf16_t*)(a.ws + WS_KB); const bf16_t* VB = (const bf16_t*)(a.ws + WS_VB);
    bf16_t* MIX = (bf16_t*)(a.ws + WS_MIX);
    int h, qrow0, q0pos, kbrow0, ncache = 0; const float* kc = nullptr; const float* vc = nullptr;
    if (u < 4096) { const int b = u >> 10, qb = u & 127; h = (u >> 7) & 7; qrow0 = b * 4096 + 32 * qb; q0pos = 32 * qb; kbrow0 = b * 4096; }
    else { const int u2 = u - 4096, b = u2 >> 4, qb = u2 & 1; h = (u2 >> 1) & 7; qrow0 = MP + b * 64 + 32 * qb; q0pos = 1024 + 32 * qb; kbrow0 = MP + b * 64 - 1024; ncache = 16;
        kc = a.in[2] + ((size_t)(l * 8 + b) * 1024) * 512 + h * 64; vc = a.in[3] + ((size_t)(l * 8 + b) * 1024) * 512 + h * 64; }
    bf16x8 qr[4];
#pragma unroll
    for (int d0 = 0; d0 < 4; ++d0) qr[d0] = *(const bf16x8*)(SQ + (size_t)(qrow0 + r32) * 512 + h * 64 + 16 * d0 + 8 * hi);
    f32x16 o[2];
#pragma unroll
    for (int i = 0; i < 16; ++i) { o[0][i] = 0.f; o[1][i] = 0.f; }
    float carry = 1.0f;
    const int qpos = q0pos + r32;
    const LAS unsigned char* vp = wl + ((lane >> 4) & 1) * 32 + (lane & 3) * 8 + (4 * hi + ((lane & 15) >> 2)) * 64;
    const int jt0 = (q0pos + 30) >> 6;
    bf16x8 kf[2][4]; u32x4 vraw[8];
    const bf16_t* kbp = KB + (size_t)(kbrow0 + r32) * 512 + h * 64 + 8 * hi;
    const bf16_t* vbp = VB + (size_t)(kbrow0 + (lane >> 2)) * 512 + h * 64 + 8 * (lane & 3);
#define SB_LOADB(JT) do { const bf16_t* kp_ = kbp + (size_t)(JT) * (64 * 512); const bf16_t* vp_ = vbp + (size_t)(JT) * (64 * 512); \
        _Pragma("unroll") for (int hf = 0; hf < 2; ++hf) _Pragma("unroll") for (int d0 = 0; d0 < 4; ++d0) kf[hf][d0] = *(const bf16x8*)(kp_ + hf * (32 * 512) + 16 * d0); \
        _Pragma("unroll") for (int p = 0; p < 8; ++p) vraw[p] = *(const u32x4*)(vp_ + (16 * (p & 3)) * 512 + 32 * (p >> 2)); } while (0)
    if (jt0 >= ncache) SB_LOADB(jt0);
    for (int jt = jt0; jt >= 0; --jt) {
        if (jt < ncache) {
            const float* kp = kc + (size_t)(64 * jt + r32) * 512 + 8 * hi;
            {
                f32x4 kx[2][4][2];
#pragma unroll
                for (int hf = 0; hf < 2; ++hf)
#pragma unroll
                    for (int d0 = 0; d0 < 4; ++d0) { const float* p = kp + (size_t)hf * 32 * 512 + 16 * d0; kx[hf][d0][0] = *(const f32x4*)p; kx[hf][d0][1] = *(const f32x4*)(p + 4); }
                __builtin_amdgcn_sched_barrier(0);
#pragma unroll
                for (int hf = 0; hf < 2; ++hf)
#pragma unroll
                    for (int d0 = 0; d0 < 4; ++d0) kf[hf][d0] = pack8f(kx[hf][d0][0], kx[hf][d0][1]);
            }
            {
                f32x4 vx[8][2];
#pragma unroll
                for (int p = 0; p < 8; ++p) { const int row = 16 * (p & 3) + (lane >> 2), dc = 32 * (p >> 2) + 8 * (lane & 3);
                    const float* sp = vc + (size_t)(64 * jt + row) * 512 + dc; vx[p][0] = *(const f32x4*)sp; vx[p][1] = *(const f32x4*)(sp + 4); }
                __builtin_amdgcn_sched_barrier(0);
#pragma unroll
                for (int p = 0; p < 8; ++p) vraw[p] = __builtin_bit_cast(u32x4, pack8f(vx[p][0], vx[p][1]));
            }
        }
        __builtin_amdgcn_sched_barrier(0);
        const bool diag = (jt == jt0);
        const bool skip1 = diag && ((q0pos & 63) == 0);
        f32x16 p0, p1;
#pragma unroll
        for (int i = 0; i < 16; ++i) { p0[i] = 0.f; p1[i] = 0.f; }
        if (!skip1) {
#pragma unroll
            for (int d0 = 0; d0 < 4; ++d0) p1 = MFMA32(kf[1][d0], qr[d0], p1);
        }
#pragma unroll
        for (int d0 = 0; d0 < 4; ++d0) p0 = MFMA32(kf[0][d0], qr[d0], p0);
#pragma unroll
        for (int p = 0; p < 8; ++p) *(LAS u32x4*)(wl + p * 1024 + lane * 16) = vraw[p];
        __builtin_amdgcn_sched_barrier(0);
        if (jt >= 1 && jt - 1 >= ncache) SB_LOADB(jt - 1);
        __builtin_amdgcn_sched_barrier(0);
        const int kbase = 64 * jt + 4 * hi;
        float run = carry;
        if (!skip1) {
            float l1[16];
            if (diag) sb_ew<true>(p1, l1, kbase + 32, qpos); else sb_ew<false>(p1, l1, kbase + 32, qpos);
            sb_cum(p1, l1, run, hi);
        }
        {
            float l0[16];
            if (diag) sb_ew<true>(p0, l0, kbase, qpos); else sb_ew<false>(p0, l0, kbase, qpos);
            sb_cum(p0, l0, run, hi);
        }
        carry = run;
        bf16x8 pa[4];
        { u32x4 w;
          w.x = cvtpk(p0[0], p0[1]); w.y = cvtpk(p0[2], p0[3]); w.z = cvtpk(p0[4], p0[5]); w.w = cvtpk(p0[6], p0[7]); pa[0] = __builtin_bit_cast(bf16x8, w);
          w.x = cvtpk(p0[8], p0[9]); w.y = cvtpk(p0[10], p0[11]); w.z = cvtpk(p0[12], p0[13]); w.w = cvtpk(p0[14], p0[15]); pa[1] = __builtin_bit_cast(bf16x8, w);
          w.x = cvtpk(p1[0], p1[1]); w.y = cvtpk(p1[2], p1[3]); w.z = cvtpk(p1[4], p1[5]); w.w = cvtpk(p1[6], p1[7]); pa[2] = __builtin_bit_cast(bf16x8, w);
          w.x = cvtpk(p1[8], p1[9]); w.y = cvtpk(p1[10], p1[11]); w.z = cvtpk(p1[12], p1[13]); w.w = cvtpk(p1[14], p1[15]); pa[3] = __builtin_bit_cast(bf16x8, w); }
        asm volatile("s_waitcnt lgkmcnt(0)" ::: "memory");
#pragma unroll
        for (int d0 = 0; d0 < 2; ++d0)
#pragma unroll
            for (int ks = 0; ks < 2; ++ks) {
                const s16x4 lo = vtr(vp + d0 * 4096 + ks * 1024), hh = vtr(vp + d0 * 4096 + ks * 1024 + 512);
                const bf16x8 vf = (bf16x8){lo[0], lo[1], lo[2], lo[3], hh[0], hh[1], hh[2], hh[3]};
                o[d0] = MFMA32(pa[ks], vf, o[d0]);
            }
        if (!skip1) {
#pragma unroll
            for (int d0 = 0; d0 < 2; ++d0)
#pragma unroll
                for (int ks = 2; ks < 4; ++ks) {
                    const s16x4 lo = vtr(vp + d0 * 4096 + ks * 1024), hh = vtr(vp + d0 * 4096 + ks * 1024 + 512);
                    const bf16x8 vf = (bf16x8){lo[0], lo[1], lo[2], lo[3], hh[0], hh[1], hh[2], hh[3]};
                    o[d0] = MFMA32(pa[ks], vf, o[d0]);
                }
        }
        asm volatile("s_waitcnt lgkmcnt(0)" ::: "memory");
        if (__builtin_amdgcn_ballot_w64(carry >= 1e-37f) == 0ull) break;
    }
#undef SB_LOADB
    LAS bf16_t* stg = (LAS bf16_t*)wl;
#pragma unroll
    for (int r = 0; r < 16; ++r) { const int orow = crow(r, hi);
#pragma unroll
        for (int d0 = 0; d0 < 2; ++d0) stg[orow * 64 + d0 * 32 + r32] = (bf16_t)f2bf(o[d0][r]); }
    asm volatile("s_waitcnt lgkmcnt(0)" ::: "memory");
#pragma unroll
    for (int i = 0; i < 4; ++i) { const int row = i * 8 + (lane >> 3), ch = lane & 7; const u32x4 v = *(const LAS u32x4*)(stg + row * 64 + ch * 8);
        *(u32x4*)(MIX + (size_t)(qrow0 + row) * D + 512 + h * 64 + ch * 8) = v; }
    asm volatile("s_waitcnt lgkmcnt(0)" ::: "memory");
}

constexpr unsigned SB_SPLIT = 2400u;
__device__ __forceinline__ void sb_queue(const Args& a, int l, unsigned* qc, unsigned lo, unsigned hi_, LAS unsigned char* wl, int lane) {
    const int wv = __builtin_amdgcn_readfirstlane((int)(threadIdx.x >> 6));
    const unsigned v = (blockIdx.x + 224u) & 255u;
    for (int k = 0; k < 3; ++k) {
        int u; unsigned p = 0u; bool slow = false;
        if (k == 0) { if (wv == 0 && v < 128u) slow = true; else p = 2048u + v * 8u + (unsigned)wv; }
        else if (k == 1) p = v * 8u + (unsigned)wv;
        else { if (wv != 4 || v >= 128u) break; p = 2048u + v * 8u; }
        if (slow) u = 4096 + (int)v;
        else if (p < 3904u) u = (int)(p / 122u) * 128 + 6 + (int)(p % 122u);
        else { const unsigned x = p - 3904u; u = (int)(x / 6u) * 128 + (int)(x % 6u); }
        sb_unit(a, l, u, wl, lane);
    }
}

constexpr int GL_BM = 0;
constexpr int GL_ALR = 16384;
constexpr int GL_WA = GL_ALR + 4096;
constexpr int GL_BA = GL_WA + 4096;
constexpr int GL_SEG = GL_BA + 256;
constexpr int GL_KDT = 32768;
constexpr int GL_QD = GL_KDT + 9216;
constexpr int GL_VT = GL_QD + 9216;
constexpr int GL_ST = GL_VT + 18432;
constexpr int GL_OL = GL_ST + 18432;
static_assert(GL_OL + 64 * 132 * 4 <= 131072, "gla lds");

__device__ __forceinline__ void gla_b(const Args& a, int l, int row0, int h, LAS unsigned char* L, int tid) {
    LAS float* Bm = (LAS float*)(L + GL_BM); LAS float* SEG = (LAS float*)(L + GL_SEG);
    const float* ALRP = (const float*)(a.ws + WS_ALRP); const float* ssq = (const float*)(a.ws + WS_SSQ) + (size_t)(2 * l) * M;
    const int d = tid & 63, tg = __builtin_amdgcn_readfirstlane(tid >> 6);
    float wa[16];
#pragma unroll
    for (int j = 0; j < 16; ++j) wa[j] = a.in[7][((size_t)l * 16 + j) * 256 + h * 64 + d];
    const float ba = a.in[8][l * 256 + h * 64 + d];
    float bl[8]; float run = 0.f;
#pragma unroll
    for (int i = 0; i < 8; ++i) {
        const int row = row0 + 8 * tg + i;
        const float sc = rsqrtf(ssq[row] * (1.0f / D) + EPS);
        const f32x4 a0 = *(const f32x4*)(ALRP + (size_t)row * 16), a1 = *(const f32x4*)(ALRP + (size_t)row * 16 + 4), a2 = *(const f32x4*)(ALRP + (size_t)row * 16 + 8), a3 = *(const f32x4*)(ALRP + (size_t)row * 16 + 12);
        float x = (a0[0] * wa[0] + a0[1] * wa[1]) + (a0[2] * wa[2] + a0[3] * wa[3]);
        x += (a1[0] * wa[4] + a1[1] * wa[5]) + (a1[2] * wa[6] + a1[3] * wa[7]);
        x += (a2[0] * wa[8] + a2[1] * wa[9]) + (a2[2] * wa[10] + a2[3] * wa[11]);
        x += (a3[0] * wa[12] + a3[1] * wa[13]) + (a3[2] * wa[14] + a3[3] * wa[15]);
        x = x * sc + ba;
        const float ls = fminf(x, 0.f) - __logf(1.0f + __expf(-fabsf(x)));
        run += ls * (1.0f / 16.0f); bl[i] = run;
    }
    SEG[tg * 64 + d] = run;
    lds_barrier();
    float off = 0.f;
#pragma unroll
    for (int g = 0; g < 7; ++g) if (g < tg) off += SEG[g * 64 + d];
#pragma unroll
    for (int i = 0; i < 8; ++i) Bm[(8 * tg + i) * 64 + d] = bl[i] + off;
    lds_barrier();
}

__device__ __forceinline__ void gla_vt(const u32x4 v0, const u32x4 v1, LAS unsigned char* L, int tid) {
    LAS bf16_t* VT = (LAS bf16_t*)(L + GL_VT);
    const int s = tid >> 3, dg = tid & 7;
    const int sx = s ^ (8 * dg);
#pragma unroll
    for (int i = 0; i < 4; ++i) { VT[(16 * dg + 2 * i) * 72 + sx] = (bf16_t)(v0[i] & 0xffffu); VT[(16 * dg + 2 * i + 1) * 72 + sx] = (bf16_t)(v0[i] >> 16);
        VT[(16 * dg + 8 + 2 * i) * 72 + sx] = (bf16_t)(v1[i] & 0xffffu); VT[(16 * dg + 8 + 2 * i + 1) * 72 + sx] = (bf16_t)(v1[i] >> 16); }
}

__device__ __forceinline__ void gla_a_item(const Args& a, int l, int item, LAS unsigned char* L, int tid, int wave, int lane) {
    const int ch = item >> 2, h = item & 3, row0 = ch * 64;
    const u32x4 kr = *(const u32x4*)((const bf16_t*)(a.ws + WS_GK) + (size_t)(row0 + (tid >> 3)) * 256 + h * 64 + 8 * (tid & 7));
    const bf16_t* vp_ = (const bf16_t*)(a.ws + WS_GV) + (size_t)(row0 + (tid >> 3)) * 512 + h * 128 + 16 * (tid & 7);
    const u32x4 pv0 = *(const u32x4*)vp_, pv1 = *(const u32x4*)(vp_ + 8);
    gla_b(a, l, row0, h, L, tid);
    LAS float* Bm = (LAS float*)(L + GL_BM); LAS bf16_t* KDT = (LAS bf16_t*)(L + GL_KDT); LAS bf16_t* VT = (LAS bf16_t*)(L + GL_VT);
    { float* bg = a.out + O_Y + (size_t)item * 4096 + tid * 8; *(f32x4*)bg = *(const LAS f32x4*)(Bm + tid * 8); *(f32x4*)(bg + 4) = *(const LAS f32x4*)(Bm + tid * 8 + 4); }
    {
        const int s = tid >> 3, dg = tid & 7;
#pragma unroll
        for (int i = 0; i < 4; ++i) { const int d = 8 * dg + 2 * i;
            KDT[d * 72 + (s ^ (8 * dg))] = (bf16_t)f2bf(bflo(kr[i]) * __expf(Bm[63 * 64 + d] - Bm[s * 64 + d]));
            KDT[(d + 1) * 72 + (s ^ (8 * dg))] = (bf16_t)f2bf(bfhi(kr[i]) * __expf(Bm[63 * 64 + d + 1] - Bm[s * 64 + d + 1])); }
    }
    gla_vt(pv0, pv1, L, tid);
    lds_barrier();
    {
        const int r32 = lane & 31, hi = lane >> 5, di = wave >> 2, vi = wave & 3;
        f32x16 acc;
#pragma unroll
        for (int i = 0; i < 16; ++i) acc[i] = 0.f;
#pragma unroll
        for (int ks = 0; ks < 4; ++ks) { const int krow = 32 * di + r32, vrow = 32 * vi + r32;
            acc = MFMA32(*(const LAS bf16x8*)(KDT + krow * 72 + ((16 * ks + 8 * hi) ^ (8 * ((krow >> 3) & 7)))), *(const LAS bf16x8*)(VT + vrow * 72 + ((16 * ks + 8 * hi) ^ (8 * ((vrow >> 4) & 7)))), acc); }
        if (item < 1024) {
            bf16_t* U = (bf16_t*)(a.ws + WS_UST) + (size_t)item * 8192;
#pragma unroll
            for (int r = 0; r < 16; ++r) U[(32 * di + crow(r, hi)) * 128 + 32 * vi + r32] = (bf16_t)f2bf(acc[r]);
        } else {
            const float* Sin = a.in[4] + (size_t)(l * 32 + item - 1024) * 8192; float* So = a.out + O_GS + (size_t)(l * 32 + item - 1024) * 8192;
#pragma unroll
            for (int r = 0; r < 16; ++r) { const int d = 32 * di + crow(r, hi), o_ = d * 128 + 32 * vi + r32; So[o_] = __expf(Bm[63 * 64 + d]) * Sin[o_] + acc[r]; }
        }
    }
    if (tid < 64) ((float*)(a.ws + WS_DEC))[item * 64 + tid] = __expf(Bm[63 * 64 + tid]);
    lds_barrier();
}

__device__ __forceinline__ void gla_scan(const Args& a, int l, int tid) {
    unsigned* U = (unsigned*)(a.ws + WS_UST); const float* DEC = (const float*)(a.ws + WS_DEC);
    for (int e = blockIdx.x * 512 + tid; e < 65536; e += gridDim.x * 512) {
        const int bh = e >> 12, idx = e & 4095, d = idx >> 6, b = bh >> 2, h = bh & 3;
        unsigned* up = U + (size_t)(b * 256 + h) * 4096 + idx;
        const float* dp = DEC + (b * 256 + h) * 64 + d;
        float S0 = 0.f, S1 = 0.f;
#pragma unroll
        for (int hf = 0; hf < 2; ++hf) {
            unsigned tv[32]; float dv[32];
#pragma unroll
            for (int i = 0; i < 32; ++i) { tv[i] = up[(size_t)(32 * hf + i) * 16384]; dv[i] = dp[(32 * hf + i) * 256]; }
            __builtin_amdgcn_sched_barrier(0);
#pragma unroll
            for (int i = 0; i < 32; ++i) { up[(size_t)(32 * hf + i) * 16384] = cvtpk(S0, S1); S0 = S0 * dv[i] + bflo(tv[i]); S1 = S1 * dv[i] + bfhi(tv[i]); }
            __builtin_amdgcn_sched_barrier(0);
        }
        *(f32x2*)(a.out + O_GP + (size_t)(l * 16 + bh) * 8192 + 2 * idx) = (f32x2){S0, S1};
    }
}

__device__ __forceinline__ void gla_c_item(const Args& a, int l, int item, LAS unsigned char* L, int tid, int wave, int lane, bool smp = false) {
    const int ch = item >> 2, h = item & 3, row0 = ch * 64;
    LAS float* Bm = (LAS float*)(L + GL_BM); LAS bf16_t* KI = (LAS bf16_t*)(L + GL_KDT); LAS bf16_t* QD = (LAS bf16_t*)(L + GL_QD);
    LAS bf16_t* VT = (LAS bf16_t*)(L + GL_VT); LAS bf16_t* ST = (LAS bf16_t*)(L + GL_ST); LAS float* OL = (LAS float*)(L + GL_OL);
    f32x4 bm0 = {0.f, 0.f, 0.f, 0.f}, bm1 = bm0;
    if (!smp) { const float* bg = (const float*)(a.out + O_Y) + (size_t)item * 4096 + tid * 8; bm0 = *(const f32x4*)bg; bm1 = *(const f32x4*)(bg + 4); }
    const u32x4 kr = *(const u32x4*)((const bf16_t*)(a.ws + WS_GK) + (size_t)(row0 + (tid >> 3)) * 256 + h * 64 + 8 * (tid & 7));
    const u32x4 qr = *(const u32x4*)((const bf16_t*)(a.ws + WS_GQ) + (size_t)(row0 + (tid >> 3)) * 256 + h * 64 + 8 * (tid & 7));
    const bf16_t* Sg = (const bf16_t*)(a.ws + WS_UST) + (size_t)item * 8192 + (tid >> 3) * 128 + 16 * (tid & 7);
    u32x4 sg0, sg1;
    if (!smp) { sg0 = *(const u32x4*)Sg; sg1 = *(const u32x4*)(Sg + 8); }
    else {
        const float* Sf = a.in[4] + (size_t)(l * 32 + item - 1024) * 8192 + (tid >> 3) * 128 + 16 * (tid & 7);
        const f32x4 f0 = *(const f32x4*)Sf, f1 = *(const f32x4*)(Sf + 4), f2 = *(const f32x4*)(Sf + 8), f3 = *(const f32x4*)(Sf + 12);
        sg0 = (u32x4){cvtpk(f0[0], f0[1]), cvtpk(f0[2], f0[3]), cvtpk(f1[0], f1[1]), cvtpk(f1[2], f1[3])};
        sg1 = (u32x4){cvtpk(f2[0], f2[1]), cvtpk(f2[2], f2[3]), cvtpk(f3[0], f3[1]), cvtpk(f3[2], f3[3])};
    }
    const bf16_t* vp_ = (const bf16_t*)(a.ws + WS_GV) + (size_t)(row0 + (tid >> 3)) * 512 + h * 128 + 16 * (tid & 7);
    const u32x4 pv0 = *(const u32x4*)vp_, pv1 = *(const u32x4*)(vp_ + 8);
    const bf16_t* gp = (const bf16_t*)(a.ws + WS_GATE) + (size_t)(row0 + (tid >> 3)) * 512 + h * 128 + 16 * (tid & 7);
    const u32x4 g0 = *(const u32x4*)gp, g1 = *(const u32x4*)(gp + 8);
    __builtin_amdgcn_sched_barrier(0);
    if (!smp) { *(LAS f32x4*)(Bm + tid * 8) = bm0; *(LAS f32x4*)(Bm + tid * 8 + 4) = bm1; lds_barrier(); }
    else gla_b(a, l, row0, h, L, tid);
    {
        const int s = tid >> 3, dg = tid & 7;
        u32x4 ko, qo;
#pragma unroll
        for (int i = 0; i < 4; ++i) { const int d = 8 * dg + 2 * i; const float b0 = Bm[s * 64 + d], b1 = Bm[s * 64 + d + 1];
            ko[i] = cvtpk(bflo(kr[i]) * __expf(-b0), bfhi(kr[i]) * __expf(-b1)); qo[i] = cvtpk(bflo(qr[i]) * __expf(b0), bfhi(qr[i]) * __expf(b1)); }
        *(LAS u32x4*)(KI + s * 72 + 8 * dg) = ko; *(LAS u32x4*)(QD + s * 72 + 8 * dg) = qo;
#pragma unroll
        for (int j = 0; j < 4; ++j) { const unsigned w0 = j < 2 ? sg0[2 * j] : sg1[2 * j - 4], w1 = j < 2 ? sg0[2 * j + 1] : sg1[2 * j - 3];
            ST[(16 * dg + 4 * j) * 72 + (s ^ (8 * dg))] = (bf16_t)(w0 & 0xffffu); ST[(16 * dg + 4 * j + 1) * 72 + (s ^ (8 * dg))] = (bf16_t)(w0 >> 16);
            ST[(16 * dg + 4 * j + 2) * 72 + (s ^ (8 * dg))] = (bf16_t)(w1 & 0xffffu); ST[(16 * dg + 4 * j + 3) * 72 + (s ^ (8 * dg))] = (bf16_t)(w1 >> 16); }
    }
    gla_vt(pv0, pv1, L, tid);
    lds_barrier();
    {
        const int r32 = lane & 31, hi = lane >> 5, ti = wave >> 2, vi = wave & 3;
        bf16x8 qf[4];
#pragma unroll
        for (int kd = 0; kd < 4; ++kd) qf[kd] = *(const LAS bf16x8*)(QD + (32 * ti + r32) * 72 + 16 * kd + 8 * hi);
        f32x16 o;
#pragma unroll
        for (int i = 0; i < 16; ++i) o[i] = 0.f;
#pragma unroll
        for (int kd = 0; kd < 4; ++kd) { const int srow = 32 * vi + r32; o = MFMA32(qf[kd], *(const LAS bf16x8*)(ST + srow * 72 + ((16 * kd + 8 * hi) ^ (8 * ((srow >> 4) & 7)))), o); }
        const int tcol = 32 * ti + r32;
#pragma unroll
        for (int sb = 0; sb < 2; ++sb) {
            if (sb <= ti) {
                f32x16 sc;
#pragma unroll
                for (int i = 0; i < 16; ++i) sc[i] = 0.f;
#pragma unroll
                for (int kd = 0; kd < 4; ++kd) sc = MFMA32(*(const LAS bf16x8*)(KI + (32 * sb + r32) * 72 + 16 * kd + 8 * hi), qf[kd], sc);
#pragma unroll
                for (int r = 0; r < 16; ++r) { const int srow = 32 * sb + crow(r, hi); if (srow > tcol) sc[r] = 0.f; }
#pragma unroll
                for (int kq = 0; kq < 2; ++kq) {
                    u32x4 w; w.x = cvtpk(sc[8 * kq], sc[8 * kq + 1]); w.y = cvtpk(sc[8 * kq + 2], sc[8 * kq + 3]); w.z = cvtpk(sc[8 * kq + 4], sc[8 * kq + 5]); w.w = cvtpk(sc[8 * kq + 6], sc[8 * kq + 7]);
                    const int ks = 2 * sb + kq;
                    const int vrow = 32 * vi + r32, vsw = 8 * ((vrow >> 4) & 7);
                    const s16x4 lo = *(const LAS s16x4*)(VT + vrow * 72 + ((16 * ks + 4 * hi) ^ vsw)), hh = *(const LAS s16x4*)(VT + vrow * 72 + ((16 * ks + 8 + 4 * hi) ^ vsw));
                    const bf16x8 vf = (bf16x8){lo[0], lo[1], lo[2], lo[3], hh[0], hh[1], hh[2], hh[3]};
                    o = MFMA32(__builtin_bit_cast(bf16x8, w), vf, o);
                }
            }
        }
#pragma unroll
        for (int r = 0; r < 16; ++r) OL[(32 * ti + crow(r, hi)) * 132 + 32 * vi + r32] = o[r];
    }
    lds_barrier();
    {
        const int t = tid >> 3, sg = tid & 7;
        float x[16]; float q = 0.f;
#pragma unroll
        for (int j = 0; j < 4; ++j) { const f32x4 v = *(const LAS f32x4*)(OL + t * 132 + 16 * sg + 4 * j); x[4 * j] = v[0]; x[4 * j + 1] = v[1]; x[4 * j + 2] = v[2]; x[4 * j + 3] = v[3]; q += (v[0] * v[0] + v[1] * v[1]) + (v[2] * v[2] + v[3] * v[3]); }
        q += __shfl_xor(q, 1); q += __shfl_xor(q, 2); q += __shfl_xor(q, 4);
        const float rs = rsqrtf(q * (1.0f / 128.0f) + EPS);
        const float* ng = a.in[11] + l * 128 + 16 * sg;
        float gt[16];
#pragma unroll
        for (int i = 0; i < 4; ++i) { gt[2 * i] = bflo(g0[i]); gt[2 * i + 1] = bfhi(g0[i]); gt[8 + 2 * i] = bflo(g1[i]); gt[8 + 2 * i + 1] = bfhi(g1[i]); }
        float y[16];
#pragma unroll
        for (int i = 0; i < 16; ++i) { const float gv = gt[i]; const float sl = gv / (1.0f + __expf(-gv)); y[i] = x[i] * rs * ng[i] * sl; }
        u32x4 w0, w1;
#pragma unroll
        for (int i = 0; i < 4; ++i) { w0[i] = cvtpk(y[2 * i], y[2 * i + 1]); w1[i] = cvtpk(y[8 + 2 * i], y[8 + 2 * i + 1]); }
        bf16_t* mp = (bf16_t*)(a.ws + WS_MIX) + (size_t)(row0 + t) * D + h * 128 + 16 * sg;
        *(u32x4*)mp = w0; *(u32x4*)(mp + 8) = w1;
    }
    lds_barrier();
}

#define XB_TMO      128
#define XB_XCNT(j)  (256  + 64 * (j))
#define XB_XSUB(j)  (1280 + 64 * (j))
#define XB_XGEN(j)  (2304 + 64 * (j))
#define XB_TOP      3328
#define XB_TOPGEN   3392
#define XCD_BAR_WORDS 3456
#define XB_SPIN_CAP (1u << 22)
__device__ __forceinline__ unsigned xb_ld(unsigned* p)              { return __hip_atomic_load(p, __ATOMIC_RELAXED, __HIP_MEMORY_SCOPE_AGENT); }
__device__ __forceinline__ unsigned xb_add(unsigned* p, unsigned v) { return __hip_atomic_fetch_add(p, v, __ATOMIC_RELAXED, __HIP_MEMORY_SCOPE_AGENT); }
__device__ __forceinline__ unsigned xb_xcc_id() { return (unsigned)__builtin_amdgcn_s_getreg((3 << 11) | 20) & 0xFu; }
#define XB_SPIN(cond, bar) do { unsigned _sp = 0; while (cond) { __builtin_amdgcn_s_sleep(1); \
    if ((++_sp & 255u) == 0u) { if (xb_ld(&(bar)[XB_TMO])) break; if (_sp > XB_SPIN_CAP) { atomicAdd(&(bar)[XB_TMO], 1u); break; } } } } while (0)
struct XcdBarrier { unsigned* bar; unsigned x; volatile LAS unsigned* st; };
__device__ __forceinline__ XcdBarrier xcd_barrier_post(unsigned* bar, volatile LAS unsigned* st) {
    XcdBarrier b; b.bar = bar; b.x = xb_xcc_id(); b.st = st;
    if (threadIdx.x == 0) (void)xb_add(&bar[XB_XCNT(b.x)], 1u);
    return b;
}
__device__ __forceinline__ void xcd_barrier_complete(unsigned* bar, unsigned x, unsigned& nloc, unsigned& nx) {
    const unsigned G = gridDim.x * gridDim.y * gridDim.z;
    unsigned sum, cnt, mine, sp = 0u;
    for (;;) {
        sum = 0u; cnt = 0u; mine = 0u;
#pragma unroll
        for (unsigned j = 0; j < 16; ++j) { const unsigned c = xb_ld(&bar[XB_XCNT(j)]); sum += c; cnt += (c > 0u) ? 1u : 0u; mine = (j == x) ? c : mine; }
        if (sum == G) break;
        __builtin_amdgcn_s_sleep(1);
        if ((++sp & 255u) == 0u) { if (xb_ld(&bar[XB_TMO])) break; if (sp > XB_SPIN_CAP) { atomicAdd(&bar[XB_TMO], 1u); break; } }
    }
    nloc = mine > 0u ? mine : 1u; nx = cnt > 0u ? cnt : 1u;
}
__device__ __forceinline__ void xcd_barrier(const XcdBarrier& b) {
    asm volatile("s_waitcnt vmcnt(0)" ::: "memory");
    __syncthreads();
    if (threadIdx.x == 0) {
        unsigned* bar = b.bar;
        __builtin_amdgcn_s_waitcnt(0);
        unsigned nloc = b.st[0], nx = b.st[1];
        if (nloc == 0u) { xcd_barrier_complete(bar, b.x, nloc, nx); b.st[0] = nloc; b.st[1] = nx; }
        const unsigned old = xb_add(&bar[XB_XSUB(b.x)], 1u);
        const unsigned gen = old / nloc;
        if (old + 1u == (gen + 1u) * nloc) {
            __builtin_amdgcn_fence(__ATOMIC_RELEASE, "agent");
            asm volatile("s_waitcnt vmcnt(0)" ::: "memory");
            const unsigned og = xb_add(&bar[XB_TOP], 1u);
            const unsigned tg = og / nx;
            if (og + 1u == (tg + 1u) * nx) xb_add(&bar[XB_TOPGEN], 1u);
            else XB_SPIN(xb_ld(&bar[XB_TOPGEN]) == tg, bar);
            __builtin_amdgcn_fence(__ATOMIC_ACQUIRE, "agent");
            xb_add(&bar[XB_XGEN(b.x)], 1u);
            asm volatile("s_waitcnt vmcnt(0)" ::: "memory");
        } else {
            XB_SPIN(xb_ld(&bar[XB_XGEN(b.x)]) == gen, bar);
            __builtin_amdgcn_fence(__ATOMIC_ACQUIRE, "agent");
            asm volatile("s_waitcnt vmcnt(0)" ::: "memory");
        }
    }
    __syncthreads();
}

__device__ __forceinline__ int fresh_tid() { int t = threadIdx.x; asm volatile("" : "+v"(t)); return t; }
#define FRESH() const int tid = fresh_tid(), lane = tid & 63, wave = __builtin_amdgcn_readfirstlane(tid >> 6)
__global__ void __launch_bounds__(512, 2) fwd_kernel(Args a) {
    extern __shared__ __attribute__((aligned(16))) unsigned char lds_raw[];
    cg::grid_group grid = cg::this_grid();
    LAS unsigned char* L = (LAS unsigned char*)lds_raw;
    const int G = gridDim.x;
    unsigned char* ws = a.ws;
    if (a.out == nullptr) grid.sync();
    if (threadIdx.x < 16) ((LAS unsigned*)(L + 131072))[threadIdx.x] = 0u;
    __syncthreads();
    (void)xcd_barrier_post((unsigned*)ws, (volatile LAS unsigned*)(L + 131072));
#define GRID_BAR() do { XcdBarrier b_; b_.bar = (unsigned*)a.ws; b_.x = xb_xcc_id(); b_.st = (volatile LAS unsigned*)(L + 131072); xcd_barrier(b_); } while (0)

    for (int rep = 0; rep < REP_PRO; ++rep) { FRESH(); prologue(a, L, tid, wave, lane); }
    GRID_BAR();

#pragma nounroll
    for (int l = 0; l < 2; ++l) {
        float* ssq = (float*)(ws + WS_SSQ);
        bf16_t* AB = (bf16_t*)(ws + WS_AB);
        for (int rep = 0; rep < REP_SMALL; ++rep) {
        { SEpiAlr EA{(float*)(ws + WS_ALRP)}; small_gemm<4, false, SEpiAlr>(L, (const void*)AB, D, (const bf16_t*)(ws + WS_WIN) + (size_t)l * NINP * D, 1, EA, fresh_tid(), 512); }
        { SEpiIn E{l, ws, a.out + O_KS + (size_t)l * MS * 512, a.out + O_VS + (size_t)l * MS * 512, a.in[9] + l * 64, a.in[10] + l * 64};
          small_gemm<2, true, SEpiIn>(L, l == 0 ? (const void*)a.in[1] : (const void*)(a.out + O_Y + (size_t)MP * D), D, (const bf16_t*)(ws + WS_WIN) + (size_t)l * NINP * D, 49, E, fresh_tid()); }
        }
        {
            pg8::Gemm g{AB, (const bf16_t*)(ws + WS_WIN) + (size_t)l * NINP * D, M, NIN, D};
            pg8::StaticOrder S; S.init(MP, NIN, G, (int)blockIdx.x);
            pg8::EpiIn E{ssq + (size_t)(2 * l) * M, (bf16_t*)(ws + WS_GQ), (bf16_t*)(ws + WS_GK), (bf16_t*)(ws + WS_GV), (bf16_t*)(ws + WS_GATE), (bf16_t*)(ws + WS_SQ), (bf16_t*)(ws + WS_KB), (bf16_t*)(ws + WS_VB),
                          a.out + O_KP + (size_t)l * MP * 512, a.out + O_VP + (size_t)l * MP * 512, a.out + O_KS + (size_t)l * MS * 512, a.out + O_VS + (size_t)l * MS * 512, a.in[9] + l * 64, a.in[10] + l * 64};
            for (int rep = 0; rep < REP_GEMM; ++rep) pg8::gemm_phase<pg8::EpiIn, pg8::StaticOrder, true, true>(L, g, S, E, fresh_tid());
        }
        GRID_BAR();
        { FRESH(); (void)tid; sb_queue(a, l, (unsigned*)ws + 4096 + 64 * (2 * l), 0u, 4224u, L + wave * 8192, lane); }
        __syncthreads();
        { FRESH(); for (int it = blockIdx.x; it < 1024; it += G) gla_a_item(a, l, it, L, tid, wave, lane); }
        GRID_BAR();
        { FRESH(); gla_scan(a, l, tid);
          if (blockIdx.x >= 128 && blockIdx.x < 160) gla_a_item(a, l, 1024 + (int)blockIdx.x - 128, L, tid, wave, lane);
          else if (blockIdx.x >= 160 && blockIdx.x < 192) gla_c_item(a, l, 1024 + (int)blockIdx.x - 160, L, tid, wave, lane, true); }
        GRID_BAR();
        { FRESH(); for (int it = blockIdx.x; it < 1024; it += G) gla_c_item(a, l, it, L, tid, wave, lane); }
        GRID_BAR();
        {
            pg8::Gemm g{(const bf16_t*)(ws + WS_MIX), (const bf16_t*)(ws + WS_WOUT) + (size_t)l * D * D, M, D, D};
            { SEpiRes E2{l == 0 ? a.in[1] : a.out + O_Y + (size_t)MP * D, a.out + O_Y + (size_t)MP * D};
              small_gemm<8, false, SEpiRes>(L, (const void*)((const bf16_t*)(ws + WS_MIX) + (size_t)MP * D), D, (const bf16_t*)(ws + WS_WOUT) + (size_t)l * D * D, 16, E2, fresh_tid()); }
            pg8::StaticOrder S; S.init(MP, D, G, (int)blockIdx.x);
            pg8::EpiRes E{l == 0 ? a.in[0] : (const float*)nullptr, AB, (float*)nullptr, AB, ssq + (size_t)(2 * l + 1) * M};
            pg8::gemm_phase<pg8::EpiRes, pg8::StaticOrder, true, true>(L, g, S, E, fresh_tid());
        }
        GRID_BAR();
        {
            pg8::Gemm g{AB, (const bf16_t*)(ws + WS_WUP) + (size_t)l * FF * D, M, FF, D};
            for (int rep = 0; rep < REP_SMALL; ++rep) { SEpiUp E2{(bf16_t*)(ws + WS_U) + (size_t)MP * FF};
              small_gemm<2, true, SEpiUp>(L, (const void*)(a.out + O_Y + (size_t)MP * D), D, (const bf16_t*)(ws + WS_WUP) + (size_t)l * FF * D, 64, E2, fresh_tid()); }
            pg8::StaticOrder S; S.init(MP, FF, G, (int)blockIdx.x);
            pg8::EpiUp E{ssq + (size_t)(2 * l + 1) * M, (bf16_t*)(ws + WS_U)};
            for (int rep = 0; rep < REP_GEMM; ++rep) pg8::gemm_phase<pg8::EpiUp, pg8::StaticOrder, true, true>(L, g, S, E, fresh_tid());
        }
        GRID_BAR();
        {
            pg8::Gemm g{(const bf16_t*)(ws + WS_U), (const bf16_t*)(ws + WS_WDN) + (size_t)l * D * FF, M, D, FF};
            { SEpiRes E2{a.out + O_Y + (size_t)MP * D, a.out + O_Y + (size_t)MP * D};
              small_gemm<8, false, SEpiRes>(L, (const void*)((const bf16_t*)(ws + WS_U) + (size_t)MP * FF), FF, (const bf16_t*)(ws + WS_WDN) + (size_t)l * D * FF, 16, E2, fresh_tid()); }
            pg8::StaticOrder S; S.init(MP, D, G, (int)blockIdx.x);
            pg8::EpiRes E{(const float*)nullptr, AB, l == 0 ? (float*)nullptr : a.out + O_Y, l == 0 ? AB : (bf16_t*)nullptr, ssq + (size_t)(l == 0 ? 2 : 3) * M};
            pg8::gemm_phase<pg8::EpiRes, pg8::StaticOrder, true, true>(L, g, S, E, fresh_tid());
        }
        if (l == 0) GRID_BAR();
    }
}

extern "C" void kernel_launch(void* const* d_in, const int* in_sizes, int n_in, void* d_out, int out_size, void* d_ws, size_t ws_size, hipStream_t stream) {
    static int grid = 0;
    if (grid == 0) {
        if (n_in != 16 || (size_t)out_size != O_END || ws_size < WS_END) { fprintf(stderr, "kernel_launch: unexpected shapes (n_in %d out %d ws %zu)\n", n_in, out_size, ws_size); grid = -1; return; }
        int dev = 0, cus = 0, per_cu = 0;
        (void)hipGetDevice(&dev);
        (void)hipDeviceGetAttribute(&cus, hipDeviceAttributeMultiprocessorCount, dev);
        if (hipFuncSetAttribute((const void*)fwd_kernel, hipFuncAttributeMaxDynamicSharedMemorySize, LDS_BYTES) != hipSuccess) { fprintf(stderr, "kernel_launch: hipFuncSetAttribute failed\n"); grid = -1; return; }
        (void)hipOccupancyMaxActiveBlocksPerMultiprocessor(&per_cu, (const void*)fwd_kernel, 512, LDS_BYTES);
        (void)hipGetLastError();
        grid = cus > 0 ? cus : 256;
        if (per_cu < 1) fprintf(stderr, "kernel_launch: occupancy query says %d blocks per CU\n", per_cu);
    }
    if (grid < 0) return;
    if (hipMemsetAsync(d_ws, 0, 32768, stream) != hipSuccess) { fprintf(stderr, "kernel_launch: memset failed\n"); return; }
    Args a{};
    for (int i = 0; i < 16; ++i) a.in[i] = (const float*)d_in[i];
    a.out = (float*)d_out; a.ws = (unsigned char*)d_ws;
    void* args[] = {&a};
    hipError_t e = hipLaunchCooperativeKernel((const void*)fwd_kernel, dim3(grid), dim3(512), args, LDS_BYTES, stream);
    if (e != hipSuccess) fprintf(stderr, "kernel_launch: cooperative launch failed: %s (grid %d)\n", hipGetErrorString(e), grid);
}
```

```cpp
#include <hip/hip_runtime.h>
#include <hip/hip_cooperative_groups.h>
#include <cstdio>
#include <cstdint>
namespace cg = cooperative_groups;

#define LAS __attribute__((address_space(3)))
typedef unsigned short bf16_t;
typedef short bf16x8 __attribute__((ext_vector_type(8)));
typedef short s16x4 __attribute__((ext_vector_type(4)));
typedef float f32x4 __attribute__((ext_vector_type(4)));
typedef float f32x2 __attribute__((ext_vector_type(2)));
typedef float f32x16 __attribute__((ext_vector_type(16)));
typedef unsigned u32x4 __attribute__((ext_vector_type(4)));
typedef unsigned u32x2 __attribute__((ext_vector_type(2)));
typedef __bf16 bf16x2_t __attribute__((ext_vector_type(2)));
typedef short v4i16_t __attribute__((ext_vector_type(4)));

constexpr int MP = 16384, MS = 512, M = MP + MS;
constexpr int D = 1024, FF = 4096, NIN = 3072, NINP = 3104;
constexpr float EPS = 1e-6f;
constexpr float LOG2E = 1.4426950408889634f;
constexpr float QSCALE = 0.125f * LOG2E;

constexpr size_t MiB = 1u << 20;
constexpr size_t WS_SSQ = 1 * MiB;
constexpr size_t WS_DEC = 1 * MiB + 512 * 1024;
constexpr size_t WS_ALRP = 2 * MiB;
constexpr size_t WS_WIN = 7 * MiB;
constexpr size_t WS_WOUT = 20 * MiB;
constexpr size_t WS_WUP = 24 * MiB;
constexpr size_t WS_WDN = 40 * MiB;
constexpr size_t WS_AB = 56 * MiB;
constexpr size_t WS_MIX = 89 * MiB;
constexpr size_t WS_U = 122 * MiB;
constexpr size_t WS_GQ = WS_U;
constexpr size_t WS_GK = WS_GQ + (size_t)M * 256 * 2;
constexpr size_t WS_GV = WS_GK + (size_t)M * 256 * 2;
constexpr size_t WS_GATE = WS_GV + (size_t)M * 512 * 2;
constexpr size_t WS_SQ = WS_GATE + (size_t)M * 512 * 2;
constexpr size_t WS_KB = WS_SQ + (size_t)M * 512 * 2;
constexpr size_t WS_VB = WS_KB + (size_t)M * 512 * 2;
constexpr size_t WS_UST = WS_VB + (size_t)M * 512 * 2;
constexpr size_t WS_END = WS_U + (size_t)M * FF * 2;
static_assert(WS_UST + (size_t)1056 * 8192 * 4 <= WS_END, "overlay");
static_assert(WS_END <= 256 * MiB, "ws");

constexpr size_t O_Y = 0;
constexpr size_t O_KP = (size_t)M * D;
constexpr size_t O_VP = O_KP + (size_t)2 * MP * 512;
constexpr size_t O_GP = O_VP + (size_t)2 * MP * 512;
constexpr size_t O_KS = O_GP + (size_t)2 * 16 * 8192;
constexpr size_t O_VS = O_KS + (size_t)2 * MS * 512;
constexpr size_t O_GS = O_VS + (size_t)2 * MS * 512;
constexpr size_t O_END = O_GS + (size_t)2 * 32 * 8192;

constexpr int LDS_BYTES = 147456;
#ifndef REP_GEMM
#define REP_GEMM 1
#endif
#ifndef REP_MIX
#define REP_MIX 1
#endif
#ifndef REP_PRO
#define REP_PRO 1
#endif
#ifndef REP_SMALL
#define REP_SMALL 1
#endif

struct Args { const float* in[16]; float* out; unsigned char* ws; };

__device__ __forceinline__ unsigned cvtpk(float lo, float hi) { f32x2 v = {lo, hi}; bf16x2_t b = __builtin_convertvector(v, bf16x2_t); return __builtin_bit_cast(unsigned, b); }
__device__ __forceinline__ unsigned f2bf(float f) { unsigned u = __builtin_bit_cast(unsigned, f); return (u + 0x7fffu + ((u >> 16) & 1u)) >> 16; }
__device__ __forceinline__ float bflo(unsigned w) { return __builtin_bit_cast(float, w << 16); }
__device__ __forceinline__ float bfhi(unsigned w) { return __builtin_bit_cast(float, w & 0xffff0000u); }
__device__ __forceinline__ int crow(int r, int hi) { return (r & 3) + 8 * (r >> 2) + 4 * hi; }
__device__ __forceinline__ float wave_sum(float v) {
#pragma unroll
    for (int o = 1; o < 64; o <<= 1) v += __shfl_xor(v, o);
    return v;
}
__device__ __forceinline__ bf16x8 pack8f(const f32x4 a, const f32x4 b) { u32x4 w; w.x = cvtpk(a[0], a[1]); w.y = cvtpk(a[2], a[3]); w.z = cvtpk(b[0], b[1]); w.w = cvtpk(b[2], b[3]); return __builtin_bit_cast(bf16x8, w); }
__device__ __forceinline__ void lds_barrier() { asm volatile("s_waitcnt lgkmcnt(0)\n\ts_barrier" ::: "memory"); }
#define MFMA32(a, b, c) __builtin_amdgcn_mfma_f32_32x32x16_bf16((a), (b), (c), 0, 0, 0)

namespace pg8 {
constexpr int BM = 256, BK = 64, HALF = 128, HTB = HALF * BK * 2, STAGE_BYTES = 8 * HTB, NXCD = 8, WGM = 8;
__host__ __device__ __forceinline__ int lds_byte(int r, int c) { const int st = (r >> 4) * 2 + (c >> 5), rr = r & 15, cc = c & 31, ob = rr * 64 + cc * 2; return st * 1024 + (ob ^ (((ob >> 9) & 1) << 5)); }
__host__ __device__ __forceinline__ void stage_rc(int b, int& R, int& C) { const int st = b / 1024, sb = b % 1024, swz = sb ^ (((sb >> 9) & 1) << 5); R = (st >> 1) * 16 + swz / 64; C = (st & 1) * 32 + (swz % 64) / 2; }
__host__ __device__ __forceinline__ int perm32(int rho) { const int n = rho >> 4, i = rho & 15; return 8 * (i >> 2) + 4 * n + (i & 3); }
struct Unit { int pm, pn; };
struct Gemm { const bf16_t* A; const bf16_t* Bt; int M, N, K; };
struct StaticOrder {
    int nM, nN, nwg, G, c;
    __host__ __device__ void init(int M_, int N_, int G_, int c_) { nM = M_ / BM; nN = N_ / BM; nwg = nM * nN; G = G_; c = c_; }
    __host__ __device__ bool next(int i, Unit& u) const {
        const long Lx = (long)i * G + c; if (Lx >= nwg) return false;
        int wgid = (int)Lx; { const int q = nwg / NXCD, r = nwg % NXCD, xcd = wgid % NXCD, off = wgid / NXCD; wgid = (xcd < r ? xcd * (q + 1) : r * (q + 1) + (xcd - r) * q) + off; }
        const int nig = WGM * nN, gid = wgid / nig, fm = gid * WGM, gsz = (nM - fm) < WGM ? (nM - fm) : WGM;
        u.pm = fm + ((wgid % nig) % gsz); u.pn = (wgid % nig) / gsz; return true;
    }
    __device__ __forceinline__ void a_ready(const Unit&) const {}
    __device__ __forceinline__ void done(const Unit&) const {}
};

template <class Epi, class Sched, bool ALIGN_EPI = false, bool SP2 = false>
__device__ __forceinline__ void gemm_phase(LAS unsigned char* lds, const Gemm g, const Sched& S, const Epi& E, const int tid) {
    const int wid = __builtin_amdgcn_readfirstlane(tid >> 6), lane = tid & 63, wr = wid >> 2, wc = wid & 3, fr = lane & 15, fq = lane >> 4;
    const int K = g.K, nt = K / BK;
    unsigned voffA[2], voffB[2];
#pragma unroll
    for (int i = 0; i < 2; ++i) { int R, C; stage_rc(tid * 16 + i * 8192, R, C); const int Rb = Epi::PERM ? ((R & ~31) + perm32(R & 31)) : R;
        voffA[i] = (unsigned)(R * K + C) * 2u; voffB[i] = (unsigned)(Rb * K + C) * 2u; }
    const size_t kstep = (size_t)(BK * 2);
    const size_t hstep = (size_t)HALF * K * 2;
    const size_t tstep = 2 * hstep;
    const unsigned ldsw = (unsigned)wid * 1024u;
    const int aoff = lds_byte(wr * 64 + fr, fq * 8), boff = lds_byte(wc * 32 + fr, fq * 8);
#define PG8_SA(b, h) (((b) * 2 + (h)) * HTB)
#define PG8_SB(b, h) ((4 + (b) * 2 + (h)) * HTB)
#define PG8_STAGE(bufoff, gbase, voff) do { _Pragma("unroll") for (int _i = 0; _i < 2; ++_i) \
        __builtin_amdgcn_global_load_lds((const unsigned*)((const char*)(gbase) + (voff)[_i]), (LAS unsigned*)(lds + (bufoff) + ldsw + _i * 8192), 16, 0, 0); } while (0)
#define PG8_LDA(dst, b, h) do { _Pragma("unroll") for (int m = 0; m < 4; ++m) _Pragma("unroll") for (int k = 0; k < 2; ++k) dst[m][k] = *(const LAS bf16x8*)(lds + PG8_SA(b, h) + aoff + m * 2048 + k * 1024); } while (0)
#define PG8_LDB(dst, b, h) do { _Pragma("unroll") for (int n = 0; n < 2; ++n) _Pragma("unroll") for (int k = 0; k < 2; ++k) dst[n][k] = *(const LAS bf16x8*)(lds + PG8_SB(b, h) + boff + n * 2048 + k * 1024); } while (0)
#define PG8_MMA(ai, bj, At, Bt) do { __builtin_amdgcn_s_setprio(1); _Pragma("unroll") for (int m = 0; m < 4; ++m) _Pragma("unroll") for (int n = 0; n < 2; ++n) _Pragma("unroll") for (int k = 0; k < 2; ++k) \
        acc[ai][bj][m][n] = __builtin_amdgcn_mfma_f32_16x16x32_bf16(Bt[n][k], At[m][k], acc[ai][bj][m][n], 0, 0, 0); __builtin_amdgcn_s_setprio(0); } while (0)
#define PG8_WAIT_V(n) asm volatile("s_waitcnt vmcnt(" #n ")" ::: "memory")
#define PG8_WAIT_L(n) asm volatile("s_waitcnt lgkmcnt(" #n ")" ::: "memory")
#define PG8_BAR __builtin_amdgcn_s_barrier()
#define PG8_SCHED __builtin_amdgcn_sched_barrier(0)
    Unit cur, nxt; int ui = 0;
    if (!S.next(0, cur)) return;
    f32x4 acc[2][2][4][2];
#pragma unroll
    for (int a = 0; a < 2; ++a)
#pragma unroll
        for (int b = 0; b < 2; ++b)
#pragma unroll
            for (int m = 0; m < 4; ++m)
#pragma unroll
                for (int n = 0; n < 2; ++n) acc[a][b][m][n] = (f32x4){0.f, 0.f, 0.f, 0.f};
    bf16x8 At[4][2], B0[2][2], B1[2][2];
    const char* cA = (const char*)g.A + (size_t)cur.pm * tstep; const char* cB = (const char*)g.Bt + (size_t)cur.pn * tstep;
    S.a_ready(cur);
    if constexpr (SP2) {
        PG8_STAGE(PG8_SB(0, 0), cB, voffB); PG8_STAGE(PG8_SB(0, 1), cB + hstep, voffB); PG8_STAGE(PG8_SA(0, 0), cA, voffA); PG8_STAGE(PG8_SA(0, 1), cA + hstep, voffA);
        if (wr == 1) PG8_BAR;
        PG8_WAIT_V(2); PG8_BAR;
        PG8_STAGE(PG8_SB(1, 0), cB + kstep, voffB); PG8_STAGE(PG8_SA(1, 0), cA + kstep, voffA); PG8_STAGE(PG8_SB(1, 1), cB + hstep + kstep, voffB);
        PG8_WAIT_V(6); PG8_BAR;
    } else {
        PG8_STAGE(PG8_SB(0, 0), cB, voffB); PG8_STAGE(PG8_SA(0, 0), cA, voffA); PG8_STAGE(PG8_SB(0, 1), cB + hstep, voffB); PG8_STAGE(PG8_SA(0, 1), cA + hstep, voffA);
        if (wr == 1) PG8_BAR;
        PG8_WAIT_V(4); PG8_BAR;
        PG8_STAGE(PG8_SB(1, 0), cB + kstep, voffB); PG8_STAGE(PG8_SA(1, 0), cA + kstep, voffA); PG8_STAGE(PG8_SB(1, 1), cB + hstep + kstep, voffB);
        PG8_WAIT_V(6); PG8_BAR;
    }
    for (;;) {
        const bool has_next = S.next(ui + 1, nxt);
        const char* nA = has_next ? (const char*)g.A + (size_t)nxt.pm * tstep : cA; const char* nB = has_next ? (const char*)g.Bt + (size_t)nxt.pn * tstep : cB;
        for (int t = 0; t < nt; t += 2) {
            const bool last = (t == nt - 2);
            const char* a1 = cA + (size_t)(t + 1) * kstep;
            const char* a2 = last ? nA : cA + (size_t)(t + 2) * kstep; const char* b2 = last ? nB : cB + (size_t)(t + 2) * kstep;
            const char* a3 = a2 + kstep; const char* b3 = b2 + kstep;
            if (last && has_next) S.a_ready(nxt);
            if constexpr (SP2) {
            PG8_LDB(B0, 0, 0); PG8_LDB(B1, 0, 1); PG8_SCHED; PG8_LDA(At, 0, 0); PG8_STAGE(PG8_SA(1, 1), a1 + hstep, voffA);
            PG8_WAIT_V(8); PG8_WAIT_L(0); PG8_BAR; PG8_MMA(0, 0, At, B0); PG8_MMA(0, 1, At, B1); PG8_BAR; PG8_SCHED;
            PG8_LDA(At, 0, 1); PG8_STAGE(PG8_SB(0, 0), b2, voffB); PG8_STAGE(PG8_SB(0, 1), b2 + hstep, voffB); PG8_STAGE(PG8_SA(0, 0), a2, voffA);
            PG8_WAIT_V(8); PG8_WAIT_L(0); PG8_BAR; PG8_MMA(1, 0, At, B0); PG8_MMA(1, 1, At, B1); PG8_BAR; PG8_SCHED;
            PG8_LDB(B0, 1, 0); PG8_LDB(B1, 1, 1); PG8_SCHED; PG8_LDA(At, 1, 0); PG8_STAGE(PG8_SA(0, 1), a2 + hstep, voffA);
            PG8_WAIT_V(8); PG8_WAIT_L(0); PG8_BAR; PG8_MMA(0, 0, At, B0); PG8_MMA(0, 1, At, B1); PG8_BAR; PG8_SCHED;
            PG8_LDA(At, 1, 1); PG8_STAGE(PG8_SB(1, 0), b3, voffB); PG8_STAGE(PG8_SB(1, 1), b3 + hstep, voffB); PG8_STAGE(PG8_SA(1, 0), a3, voffA);
            PG8_WAIT_V(8); PG8_WAIT_L(0); PG8_BAR; PG8_MMA(1, 0, At, B0); PG8_MMA(1, 1, At, B1); PG8_BAR; PG8_SCHED;
            } else {
            PG8_LDB(B0, 0, 0); PG8_SCHED; PG8_LDA(At, 0, 0); PG8_STAGE(PG8_SA(1, 1), a1 + hstep, voffA);
            PG8_WAIT_L(8); PG8_BAR; PG8_WAIT_L(0); PG8_MMA(0, 0, At, B0); PG8_BAR; PG8_SCHED;
            PG8_LDB(B1, 0, 1); PG8_STAGE(PG8_SB(0, 0), b2, voffB);
            PG8_BAR; PG8_WAIT_L(0); PG8_MMA(0, 1, At, B1); PG8_BAR;
            PG8_LDA(At, 0, 1); PG8_STAGE(PG8_SA(0, 0), a2, voffA);
            PG8_BAR; PG8_WAIT_L(0); PG8_MMA(1, 0, At, B0); PG8_BAR; PG8_SCHED;
            PG8_STAGE(PG8_SB(0, 1), b2 + hstep, voffB);
            PG8_WAIT_V(6); PG8_BAR; PG8_MMA(1, 1, At, B1); PG8_BAR;
            PG8_LDB(B0, 1, 0); PG8_SCHED; PG8_LDA(At, 1, 0); PG8_STAGE(PG8_SA(0, 1), a2 + hstep, voffA);
            PG8_WAIT_L(8); PG8_BAR; PG8_WAIT_L(0); PG8_MMA(0, 0, At, B0); PG8_BAR; PG8_SCHED;
            PG8_LDB(B1, 1, 1); PG8_STAGE(PG8_SB(1, 0), b3, voffB);
            PG8_BAR; PG8_WAIT_L(0); PG8_MMA(0, 1, At, B1); PG8_BAR;
            PG8_LDA(At, 1, 1); PG8_STAGE(PG8_SA(1, 0), a3, voffA);
            PG8_BAR; PG8_WAIT_L(0); PG8_MMA(1, 0, At, B0); PG8_BAR; PG8_SCHED;
            PG8_STAGE(PG8_SB(1, 1), b3 + hstep, voffB);
            PG8_WAIT_V(6); PG8_BAR; PG8_MMA(1, 1, At, B1); PG8_BAR;
            }
        }
        if constexpr (ALIGN_EPI) { if (wr == 0) PG8_BAR; }
        E(acc, cur, wr, wc, fr, fq); S.done(cur);
        if (!has_next) break;
#pragma unroll
        for (int a = 0; a < 2; ++a)
#pragma unroll
            for (int b = 0; b < 2; ++b)
#pragma unroll
                for (int m = 0; m < 4; ++m)
#pragma unroll
                    for (int n = 0; n < 2; ++n) acc[a][b][m][n] = (f32x4){0.f, 0.f, 0.f, 0.f};
        cur = nxt; cA = nA; cB = nB; ++ui;
        if constexpr (ALIGN_EPI) { if (wr == 1) PG8_BAR; }
    }
    PG8_WAIT_V(0);
    if constexpr (!ALIGN_EPI) { if (wr == 0) PG8_BAR; }
    PG8_BAR;
#undef PG8_SA
#undef PG8_SB
#undef PG8_STAGE
#undef PG8_LDA
#undef PG8_LDB
#undef PG8_MMA
#undef PG8_WAIT_V
#undef PG8_WAIT_L
#undef PG8_BAR
#undef PG8_SCHED
}


struct EpiIn {
    static constexpr bool PERM = true;
    const float* ssq; bf16_t *GQ, *GK, *GV, *GATE, *SQ, *KB, *VB; float *Kp, *Vp, *Ks, *Vs; const float *qg, *kg;
    __device__ __forceinline__ void operator()(const f32x4 (&acc)[2][2][4][2], const Unit& u, int wr, int wc, int fr, int fq) const {
        const int pn = u.pn;
        float sv[2][4];
#pragma unroll
        for (int ai = 0; ai < 2; ++ai)
#pragma unroll
            for (int m = 0; m < 4; ++m) sv[ai][m] = ssq[u.pm * BM + ai * HALF + wr * 64 + m * 16 + fr];
        f32x4 gg[2][2];
        { const float* gp0 = (pn < 8) ? qg : kg;
#pragma unroll
          for (int bj = 0; bj < 2; ++bj) { gg[bj][0] = *(const f32x4*)(gp0 + 32 * bj + 8 * fq); gg[bj][1] = *(const f32x4*)(gp0 + 32 * bj + 8 * fq + 4); } }
        __builtin_amdgcn_sched_barrier(0);
#pragma unroll
        for (int ai = 0; ai < 2; ++ai)
#pragma unroll
            for (int m = 0; m < 4; ++m) {
                const int row = u.pm * BM + ai * HALF + wr * 64 + m * 16 + fr;
                const float s = rsqrtf(sv[ai][m] * (1.0f / D) + EPS);
                f32x4 v[2][2];
#pragma unroll
                for (int bj = 0; bj < 2; ++bj)
#pragma unroll
                    for (int n = 0; n < 2; ++n) v[bj][n] = acc[ai][bj][m][n] * s;
                if (pn < 6) {
                    bf16_t* base; int pitch, c0; float sc = 1.f;
                    if (pn == 0) { base = GQ; pitch = 256; c0 = 0; sc = 0.125f; }
                    else if (pn == 1) { base = GK; pitch = 256; c0 = 0; }
                    else if (pn < 4) { base = GV; pitch = 512; c0 = (pn - 2) * 256; }
                    else { base = GATE; pitch = 512; c0 = (pn - 4) * 256; }
#pragma unroll
                    for (int bj = 0; bj < 2; ++bj) {
                        const f32x4 a = v[bj][0] * sc, b = v[bj][1] * sc;
                        u32x4 w; w.x = cvtpk(a[0], a[1]); w.y = cvtpk(a[2], a[3]); w.z = cvtpk(b[0], b[1]); w.w = cvtpk(b[2], b[3]);
                        *(u32x4*)(base + (size_t)row * pitch + c0 + bj * HALF + wc * 32 + 8 * fq) = w;
                    }
                } else if (pn < 10) {
                    float q = 0.f;
#pragma unroll
                    for (int bj = 0; bj < 2; ++bj)
#pragma unroll
                        for (int n = 0; n < 2; ++n) { const f32x4 x = v[bj][n]; q += (x[0] * x[0] + x[1] * x[1]) + (x[2] * x[2] + x[3] * x[3]); }
                    q += __shfl_xor(q, 16); q += __shfl_xor(q, 32);
                    const float rs = rsqrtf(q * (1.0f / 64.0f) + EPS);
                    const bool isq = pn < 8;
                    const float mul = isq ? rs * QSCALE : rs;
                    const size_t orow = (u.pm < 64) ? (size_t)row : (size_t)(row - MP);
                    float* kout = (u.pm < 64) ? Kp : Ks;
#pragma unroll
                    for (int bj = 0; bj < 2; ++bj) {
                        const int j = 32 * bj + 8 * fq;
                        const int col = (pn & 1) * 256 + 64 * wc + j;
                        const f32x4 g0 = gg[bj][0], g1 = gg[bj][1];
                        const f32x4 a = v[bj][0] * g0 * mul, b = v[bj][1] * g1 * mul;
                        u32x4 w; w.x = cvtpk(a[0], a[1]); w.y = cvtpk(a[2], a[3]); w.z = cvtpk(b[0], b[1]); w.w = cvtpk(b[2], b[3]);
                        if (isq) { *(u32x4*)(SQ + (size_t)row * 512 + col) = w; }
                        else { *(u32x4*)(KB + (size_t)row * 512 + col) = w; __builtin_nontemporal_store(a, (f32x4*)(kout + orow * 512 + col)); __builtin_nontemporal_store(b, (f32x4*)(kout + orow * 512 + col + 4)); }
                    }
                } else {
                    const size_t orow = (u.pm < 64) ? (size_t)row : (size_t)(row - MP);
                    float* vout = (u.pm < 64) ? Vp : Vs;
#pragma unroll
                    for (int bj = 0; bj < 2; ++bj) {
                        const int col = (pn - 10) * 256 + bj * HALF + wc * 32 + 8 * fq;
                        const f32x4 a = v[bj][0], b = v[bj][1];
                        u32x4 w; w.x = cvtpk(a[0], a[1]); w.y = cvtpk(a[2], a[3]); w.z = cvtpk(b[0], b[1]); w.w = cvtpk(b[2], b[3]);
                        *(u32x4*)(VB + (size_t)row * 512 + col) = w; __builtin_nontemporal_store(a, (f32x4*)(vout + orow * 512 + col)); __builtin_nontemporal_store(b, (f32x4*)(vout + orow * 512 + col + 4));
                    }
                }
            }
    }
};

struct EpiRes {
    static constexpr bool PERM = true;
    const float* res_f; const bf16_t* res_b;
    float* out; bf16_t* outb; float* ssq;
    __device__ __forceinline__ void operator()(const f32x4 (&acc)[2][2][4][2], const Unit& u, int wr, int wc, int fr, int fq) const {
#pragma unroll
        for (int ai = 0; ai < 2; ++ai)
#pragma unroll
        for (int mp = 0; mp < 2; ++mp) {
            f32x4 rv[2][2][2];
            if (res_f) {
#pragma unroll
                for (int mm = 0; mm < 2; ++mm) {
                    const int row = u.pm * BM + ai * HALF + wr * 64 + (2 * mp + mm) * 16 + fr;
                    const float* rp = res_f + (size_t)row * D;
#pragma unroll
                    for (int bj = 0; bj < 2; ++bj) { const int col = u.pn * BM + bj * HALF + wc * 32 + 8 * fq; rv[mm][bj][0] = *(const f32x4*)(rp + col); rv[mm][bj][1] = *(const f32x4*)(rp + col + 4); }
                }
            } else {
                u32x4 rb[2][2];
#pragma unroll
                for (int mm = 0; mm < 2; ++mm) {
                    const int row = u.pm * BM + ai * HALF + wr * 64 + (2 * mp + mm) * 16 + fr;
#pragma unroll
                    for (int bj = 0; bj < 2; ++bj) rb[mm][bj] = *(const u32x4*)(res_b + (size_t)row * D + u.pn * BM + bj * HALF + wc * 32 + 8 * fq);
                }
                __builtin_amdgcn_sched_barrier(0);
#pragma unroll
                for (int mm = 0; mm < 2; ++mm)
#pragma unroll
                    for (int bj = 0; bj < 2; ++bj) { const u32x4 w = rb[mm][bj];
                        rv[mm][bj][0] = (f32x4){bflo(w.x), bfhi(w.x), bflo(w.y), bfhi(w.y)}; rv[mm][bj][1] = (f32x4){bflo(w.z), bfhi(w.z), bflo(w.w), bfhi(w.w)}; }
            }
            __builtin_amdgcn_sched_barrier(0);
#pragma unroll
            for (int mm = 0; mm < 2; ++mm) {
                const int m = 2 * mp + mm;
                const int row = u.pm * BM + ai * HALF + wr * 64 + m * 16 + fr;
                float q = 0.f;
#pragma unroll
                for (int bj = 0; bj < 2; ++bj) {
                    const int col = u.pn * BM + bj * HALF + wc * 32 + 8 * fq;
                    const f32x4 a = acc[ai][bj][m][0] + rv[mm][bj][0], b = acc[ai][bj][m][1] + rv[mm][bj][1];
                    if (out) { __builtin_nontemporal_store(a, (f32x4*)(out + (size_t)row * D + col)); __builtin_nontemporal_store(b, (f32x4*)(out + (size_t)row * D + col + 4)); }
                    if (outb) {
                        u32x4 w; w.x = cvtpk(a[0], a[1]); w.y = cvtpk(a[2], a[3]); w.z = cvtpk(b[0], b[1]); w.w = cvtpk(b[2], b[3]);
                        *(u32x4*)(outb + (size_t)row * D + col) = w;
                        q += (a[0] * a[0] + a[1] * a[1]) + (a[2] * a[2] + a[3] * a[3]) + (b[0] * b[0] + b[1] * b[1]) + (b[2] * b[2] + b[3] * b[3]);
                    }
                }
                if (outb) { q += __shfl_xor(q, 16); q += __shfl_xor(q, 32); if (fq == 0) atomicAdd(ssq + row, q); }
            }
            __builtin_amdgcn_sched_barrier(0);
        }
    }
};

struct EpiUp {
    static constexpr bool PERM = true;
    const float* ssq; bf16_t* U;
    __device__ __forceinline__ void operator()(const f32x4 (&acc)[2][2][4][2], const Unit& u, int wr, int wc, int fr, int fq) const {
        float sv[2][4];
#pragma unroll
        for (int ai = 0; ai < 2; ++ai)
#pragma unroll
            for (int m = 0; m < 4; ++m) sv[ai][m] = ssq[u.pm * BM + ai * HALF + wr * 64 + m * 16 + fr];
        __builtin_amdgcn_sched_barrier(0);
#pragma unroll
        for (int ai = 0; ai < 2; ++ai)
#pragma unroll
            for (int m = 0; m < 4; ++m) {
                const int row = u.pm * BM + ai * HALF + wr * 64 + m * 16 + fr;
                const float s = rsqrtf(sv[ai][m] * (1.0f / D) + EPS);
#pragma unroll
                for (int bj = 0; bj < 2; ++bj) {
                    const int col = u.pn * BM + bj * HALF + wc * 32 + 8 * fq;
                    f32x4 a = acc[ai][bj][m][0] * s, b = acc[ai][bj][m][1] * s;
#pragma unroll
                    for (int i = 0; i < 4; ++i) { const float x = fmaxf(a[i], 0.f), y = fmaxf(b[i], 0.f); a[i] = x * x; b[i] = y * y; }
                    u32x4 w; w.x = cvtpk(a[0], a[1]); w.y = cvtpk(a[2], a[3]); w.z = cvtpk(b[0], b[1]); w.w = cvtpk(b[2], b[3]);
                    *(u32x4*)(U + (size_t)row * FF + col) = w;
                }
            }
    }
};
}

__device__ __forceinline__ int win_src_col(int pb) {
    const int pn = pb >> 3, pc0 = (pb & 7) * 32;
    int logical = pc0;
    if (pn >= 6 && pn <= 9) { const int bj = pc0 >> 7, wc = (pc0 & 127) >> 5; logical = 64 * wc + 32 * bj; }
    const int Lc = 256 * pn + logical;
    return Lc < 1536 ? Lc : Lc + 16;
}
__device__ __forceinline__ void transpose_item(const float* W, int ldw, int src_col0, bool alr, int k0, bf16_t* WT, int K, int dst_row0, const float* g, LAS float* scr, int lane, bool late = false) {
    const int r8 = lane >> 3, c4 = lane & 7, coff = alr ? 4 * (c4 & 3) : 4 * c4;
    f32x4 wv[8]; float gv[8];
#pragma unroll
    for (int u = 0; u < 8; ++u) { const int kk = 8 * u + r8; wv[u] = __builtin_nontemporal_load((const f32x4*)(W + (size_t)(k0 + kk) * ldw + src_col0 + coff)); gv[u] = g ? g[k0 + kk] : 1.0f; }
    __builtin_amdgcn_sched_barrier(0);
#pragma unroll
    for (int u = 0; u < 8; ++u) { const int kk = 8 * u + r8; LAS float* d_ = scr + kk * 33 + 4 * c4;
        d_[0] = wv[u][0] * gv[u]; d_[1] = wv[u][1] * gv[u]; d_[2] = wv[u][2] * gv[u]; d_[3] = wv[u][3] * gv[u]; }
    asm volatile("s_waitcnt lgkmcnt(0)" ::: "memory");
    const int c = lane & 7;
#pragma unroll
    for (int j = 0; j < 4; ++j) { const int n = (lane >> 3) + 8 * j; const LAS float* s = scr + (8 * c) * 33 + n;
        u32x4 o; o.x = cvtpk(s[0 * 33], s[1 * 33]); o.y = cvtpk(s[2 * 33], s[3 * 33]); o.z = cvtpk(s[4 * 33], s[5 * 33]); o.w = cvtpk(s[6 * 33], s[7 * 33]);
        u32x4* dp_ = (u32x4*)(WT + (size_t)(dst_row0 + n) * K + k0 + 8 * c);
        if (late) __builtin_nontemporal_store(o, dp_); else *dp_ = o; }
    asm volatile("s_waitcnt lgkmcnt(0)" ::: "memory");
}

__device__ __forceinline__ void prologue(const Args& a, LAS unsigned char* L, int tid, int wave, int lane) {
    unsigned char* ws = a.ws;
    LAS float* scr = (LAS float*)(L + wave * 16384);
    const int gw = blockIdx.x * 8 + wave, NGW = gridDim.x * 8;
    constexpr int I_IN = 16 * 97, I_OUT = 16 * 32, I_UP = 16 * 128, I_DN = 64 * 32, I_L = I_IN + I_OUT + I_UP + I_DN;
    for (int it = gw; it < 2 * I_L; it += NGW) {
        const int l = it / I_L; int r = it % I_L;
        if (r < I_IN) { const int kb = r / 97, pb = r % 97; const bool alr = pb == 96;
            transpose_item(a.in[6] + (size_t)l * D * 3088, 3088, alr ? 1536 : win_src_col(pb), alr, 64 * kb, (bf16_t*)(ws + WS_WIN) + (size_t)l * NINP * D, D, 32 * pb, a.in[5] + l * D, scr, lane, l == 1); continue; }
        r -= I_IN;
        if (r < I_OUT) { const int kb = r / 32, nb = r % 32;
            transpose_item(a.in[12] + (size_t)l * D * D, D, 32 * nb, false, 64 * kb, (bf16_t*)(ws + WS_WOUT) + (size_t)l * D * D, D, 32 * nb, nullptr, scr, lane, l == 1); continue; }
        r -= I_OUT;
        if (r < I_UP) { const int kb = r / 128, nb = r % 128;
            transpose_item(a.in[14] + (size_t)l * D * FF, FF, 32 * nb, false, 64 * kb, (bf16_t*)(ws + WS_WUP) + (size_t)l * FF * D, D, 32 * nb, a.in[13] + l * D, scr, lane, l == 1); continue; }
        r -= I_UP;
        { const int kb = r / 32, nb = r % 32;
            transpose_item(a.in[15] + (size_t)l * FF * D, D, 32 * nb, false, 64 * kb, (bf16_t*)(ws + WS_WDN) + (size_t)l * D * FF, FF, 32 * nb, nullptr, scr, lane, l == 1); }
    }
    float* ssq = (float*)(ws + WS_SSQ);
    bf16_t* AB = (bf16_t*)(ws + WS_AB);
    for (int m = gw; m < M; m += NGW) {
        const float* xr = (m < MP) ? a.in[0] + (size_t)m * D : a.in[1] + (size_t)(m - MP) * D;
        const f32x4* x4 = (const f32x4*)xr + lane;
        f32x4 v[4]; float s = 0.f;
#pragma unroll
        for (int j = 0; j < 4; ++j) { v[j] = __builtin_nontemporal_load(x4 + 64 * j); s += (v[j].x * v[j].x + v[j].y * v[j].y) + (v[j].z * v[j].z + v[j].w * v[j].w); }
        s = wave_sum(s);
        u32x2* o8 = (u32x2*)(AB + (size_t)m * D) + lane;
#pragma unroll
        for (int j = 0; j < 4; ++j) { u32x2 w; w.x = cvtpk(v[j].x, v[j].y); w.y = cvtpk(v[j].z, v[j].w); o8[64 * j] = w; }
        if (lane == 0) ssq[m] = s;
    }
    for (int i = blockIdx.x * 512 + tid; i < 3 * M; i += gridDim.x * 512) ssq[M + i] = 0.f;
}

template <int KS, bool AF32, class EPI>
__device__ __forceinline__ void small_gemm(LAS unsigned char* L, const void* Abase, int K, const bf16_t* Bt, int ncg, const EPI& E, int tid, int nrb = 16) {
    const int lane = tid & 63, wave = __builtin_amdgcn_readfirstlane(tid >> 6), r32 = lane & 31, hi = lane >> 5;
    constexpr int GPW = 8 / KS;
    constexpr int PITCH = 144;
    const int grp = wave / KS, ks = wave % KS;
    const int ntasks = nrb * ncg, per_pass = gridDim.x * GPW, npass = (ntasks + per_pass - 1) / per_pass;
    LAS float* RED = (LAS float*)L; LAS float* SSP = (LAS float*)(L + 114688); LAS float* SSR = (LAS float*)(L + 114688 + 1024);
    LAS unsigned char* SA = L + wave * (3 * 32 * PITCH); LAS unsigned char* SB0 = SA + 32 * PITCH; LAS unsigned char* SB1 = SB0 + 32 * PITCH;
    for (int p = 0; p < npass; ++p) {
        const int task = (p * gridDim.x + blockIdx.x) * GPW + grp;
        const bool act = task < ntasks;
        f32x16 acc0, acc1;
#pragma unroll
        for (int i = 0; i < 16; ++i) { acc0[i] = 0.f; acc1[i] = 0.f; }
        float q8[8];
#pragma unroll
        for (int i = 0; i < 8; ++i) q8[i] = 0.f;
        int rb = 0, cg = 0;
        if (act) {
            rb = task / ncg; cg = task - rb * ncg;
            const int Kw = K / KS, nb = Kw / 64, k0 = ks * Kw;
            const bf16_t* b0p = Bt + (size_t)(E.brow(cg, 0) + (lane >> 3)) * K + k0 + 8 * (lane & 7);
            const bf16_t* b1p = Bt + (size_t)(E.brow(cg, 1) + (lane >> 3)) * K + k0 + 8 * (lane & 7);
            const float* afp = (const float*)Abase + (size_t)(32 * rb + (lane >> 4)) * K + k0 + 4 * (lane & 15);
            const bf16_t* abp = (const bf16_t*)Abase + (size_t)(32 * rb + (lane >> 3)) * K + k0 + 8 * (lane & 7);
            f32x4 xa[8]; u32x4 ab[4], bb0[4], bb1[4];
#define SG_LOAD(kb) do { \
                if constexpr (AF32) { _Pragma("unroll") for (int i = 0; i < 8; ++i) xa[i] = *(const f32x4*)(afp + (size_t)(4 * i) * K + 64 * (kb)); } \
                else { _Pragma("unroll") for (int i = 0; i < 4; ++i) ab[i] = *(const u32x4*)(abp + (size_t)(8 * i) * K + 64 * (kb)); } \
                _Pragma("unroll") for (int i = 0; i < 4; ++i) { bb0[i] = *(const u32x4*)(b0p + (size_t)(8 * i) * K + 64 * (kb)); bb1[i] = *(const u32x4*)(b1p + (size_t)(8 * i) * K + 64 * (kb)); } } while (0)
            SG_LOAD(0);
            for (int kb = 0; kb < nb; ++kb) {
                __builtin_amdgcn_sched_barrier(0);
                if constexpr (AF32) {
#pragma unroll
                    for (int i = 0; i < 8; ++i) { const f32x4 x = xa[i]; q8[i] += (x[0] * x[0] + x[1] * x[1]) + (x[2] * x[2] + x[3] * x[3]);
                        u32x2 w; w.x = cvtpk(x[0], x[1]); w.y = cvtpk(x[2], x[3]); *(LAS u32x2*)(SA + (4 * i + (lane >> 4)) * PITCH + 8 * (lane & 15)) = w; }
                } else {
#pragma unroll
                    for (int i = 0; i < 4; ++i) *(LAS u32x4*)(SA + (8 * i + (lane >> 3)) * PITCH + 16 * (lane & 7)) = ab[i];
                }
#pragma unroll
                for (int i = 0; i < 4; ++i) { *(LAS u32x4*)(SB0 + (8 * i + (lane >> 3)) * PITCH + 16 * (lane & 7)) = bb0[i]; *(LAS u32x4*)(SB1 + (8 * i + (lane >> 3)) * PITCH + 16 * (lane & 7)) = bb1[i]; }
                __builtin_amdgcn_sched_barrier(0);
                if (kb + 1 < nb) SG_LOAD(kb + 1);
                __builtin_amdgcn_sched_barrier(0);
#pragma unroll
                for (int j = 0; j < 4; ++j) {
                    const bf16x8 af = *(const LAS bf16x8*)(SA + r32 * PITCH + 32 * j + 16 * hi);
                    const bf16x8 f0 = *(const LAS bf16x8*)(SB0 + r32 * PITCH + 32 * j + 16 * hi), f1 = *(const LAS bf16x8*)(SB1 + r32 * PITCH + 32 * j + 16 * hi);
                    acc0 = MFMA32(af, f0, acc0); acc1 = MFMA32(af, f1, acc1);
                }
            }
#undef SG_LOAD
        }
        lds_barrier();
        if (ks != 0) {
#pragma unroll
            for (int i = 0; i < 16; ++i) { RED[(wave * 32 + i) * 64 + lane] = acc0[i]; RED[(wave * 32 + 16 + i) * 64 + lane] = acc1[i]; }
        }
        if (AF32) {
#pragma unroll
            for (int i = 0; i < 8; ++i) { float q = q8[i]; q += __shfl_xor(q, 1); q += __shfl_xor(q, 2); q += __shfl_xor(q, 4); q += __shfl_xor(q, 8);
                if ((lane & 15) == 0) SSP[wave * 32 + 4 * i + (lane >> 4)] = q; }
        }
        lds_barrier();
        if (ks == 0 && act) {
#pragma unroll
            for (int w2 = 1; w2 < KS; ++w2)
#pragma unroll
                for (int i = 0; i < 16; ++i) { acc0[i] += RED[((wave + w2) * 32 + i) * 64 + lane]; acc1[i] += RED[((wave + w2) * 32 + 16 + i) * 64 + lane]; }
            float ss[16];
            if (AF32) {
                float t = 0.f;
#pragma unroll
                for (int w2 = 0; w2 < KS; ++w2) t += SSP[(wave + w2) * 32 + r32];
                SSR[grp * 32 + r32] = t;
#pragma unroll
                for (int r = 0; r < 16; ++r) ss[r] = SSR[grp * 32 + crow(r, hi)];
            } else {
#pragma unroll
                for (int r = 0; r < 16; ++r) ss[r] = 0.f;
            }
            E(acc0, acc1, rb, cg, r32, hi, ss);
        }
        lds_barrier();
    }
}

struct SEpiIn {
    int l; unsigned char* ws; float* Ks; float* Vs; const float* qg; const float* kg;
    __device__ __forceinline__ int brow(int cg, int j) const {
        if (cg == 48) return NIN;
        const int pn = cg >> 2, hd = cg & 3;
        if (pn >= 6 && pn <= 9) return 256 * pn + 128 * j + 32 * hd;
        return 64 * cg + 32 * j;
    }
    __device__ __forceinline__ void operator()(const f32x16& acc0, const f32x16& acc1, int rb, int cg, int r32, int hi, const float (&ss)[16]) const {
        const int pn = cg >> 2, hd = cg & 3;
        if (cg == 48) {
            float* ALRP = (float*)(ws + WS_ALRP); float* ssq = (float*)(ws + WS_SSQ) + (size_t)(2 * l) * M;
#pragma unroll
            for (int r = 0; r < 16; ++r) { const int row = MP + 32 * rb + crow(r, hi);
                if (r32 < 16) ALRP[(size_t)row * 16 + r32] = acc0[r];
                if (r32 == 16) ssq[row] = ss[r]; }
            return;
        }
#pragma unroll
        for (int r = 0; r < 16; ++r) {
            const int rs_ = 32 * rb + crow(r, hi), row = MP + rs_;
            const float s = rsqrtf(ss[r] * (1.0f / D) + EPS);
            const float v0 = acc0[r] * s, v1 = acc1[r] * s;
            if (pn < 6) {
                bf16_t* base; int pitch, c0; float sc = 1.f;
                if (pn == 0) { base = (bf16_t*)(ws + WS_GQ); pitch = 256; c0 = 64 * cg; sc = 0.125f; }
                else if (pn == 1) { base = (bf16_t*)(ws + WS_GK); pitch = 256; c0 = 64 * (cg - 4); }
                else if (pn < 4) { base = (bf16_t*)(ws + WS_GV); pitch = 512; c0 = 64 * (cg - 8); }
                else { base = (bf16_t*)(ws + WS_GATE); pitch = 512; c0 = 64 * (cg - 16); }
                base[(size_t)row * pitch + c0 + r32] = (bf16_t)f2bf(v0 * sc); base[(size_t)row * pitch + c0 + 32 + r32] = (bf16_t)f2bf(v1 * sc);
            } else if (pn < 10) {
                float q = v0 * v0 + v1 * v1;
                q += __shfl_xor(q, 1); q += __shfl_xor(q, 2); q += __shfl_xor(q, 4); q += __shfl_xor(q, 8); q += __shfl_xor(q, 16);
                const float rn = rsqrtf(q * (1.0f / 64.0f) + EPS);
                const bool isq = pn < 8;
                const float* gp = isq ? qg : kg;
                const int col = ((pn & 1) * 4 + hd) * 64 + r32;
                const float a0 = v0 * rn * gp[r32], a1 = v1 * rn * gp[32 + r32];
                if (isq) { bf16_t* SQ = (bf16_t*)(ws + WS_SQ); SQ[(size_t)row * 512 + col] = (bf16_t)f2bf(a0 * QSCALE); SQ[(size_t)row * 512 + col + 32] = (bf16_t)f2bf(a1 * QSCALE); }
                else { bf16_t* KB = (bf16_t*)(ws + WS_KB); KB[(size_t)row * 512 + col] = (bf16_t)f2bf(a0); KB[(size_t)row * 512 + col + 32] = (bf16_t)f2bf(a1);
                    Ks[(size_t)rs_ * 512 + col] = a0; Ks[(size_t)rs_ * 512 + col + 32] = a1; }
            } else {
                const int col = 64 * (cg - 40) + r32; bf16_t* VB = (bf16_t*)(ws + WS_VB);
                VB[(size_t)row * 512 + col] = (bf16_t)f2bf(v0); VB[(size_t)row * 512 + col + 32] = (bf16_t)f2bf(v1);
                Vs[(size_t)rs_ * 512 + col] = v0; Vs[(size_t)rs_ * 512 + col + 32] = v1;
            }
        }
    }
};
struct SEpiAlr {
    float* ALRP;
    __device__ __forceinline__ int brow(int cg, int j) const { return NIN; }
    __device__ __forceinline__ void operator()(const f32x16& acc0, const f32x16& acc1, int rb, int cg, int r32, int hi, const float (&ss)[16]) const {
        if (r32 < 16) {
#pragma unroll
            for (int r = 0; r < 16; ++r) ALRP[(size_t)(32 * rb + crow(r, hi)) * 16 + r32] = acc0[r];
        }
    }
};
struct SEpiRes {
    const float* res; float* out;
    __device__ __forceinline__ int brow(int cg, int j) const { return 64 * cg + 32 * j; }
    __device__ __forceinline__ void operator()(const f32x16& acc0, const f32x16& acc1, int rb, int cg, int r32, int hi, const float (&ss)[16]) const {
#pragma unroll
        for (int r = 0; r < 16; ++r) { const size_t o = (size_t)(32 * rb + crow(r, hi)) * D + 64 * cg + r32;
            out[o] = res[o] + acc0[r]; out[o + 32] = res[o + 32] + acc1[r]; }
    }
};
struct SEpiUp {
    bf16_t* U;
    __device__ __forceinline__ int brow(int cg, int j) const { return 64 * cg + 32 * j; }
    __device__ __forceinline__ void operator()(const f32x16& acc0, const f32x16& acc1, int rb, int cg, int r32, int hi, const float (&ss)[16]) const {
#pragma unroll
        for (int r = 0; r < 16; ++r) { const size_t o = (size_t)(32 * rb + crow(r, hi)) * FF + 64 * cg + r32;
            const float s = rsqrtf(ss[r] * (1.0f / D) + EPS); const float x = fmaxf(acc0[r] * s, 0.f), y = fmaxf(acc1[r] * s, 0.f);
            U[o] = (bf16_t)f2bf(x * x); U[o + 32] = (bf16_t)f2bf(y * y); }
    }
};

__device__ __forceinline__ void alr_phase(const Args& a, int l, int wave, int lane) {
    const int r32 = lane & 31, hi = lane >> 5;
    const bf16_t* AB = (const bf16_t*)(a.ws + WS_AB);
    const bf16_t* Wt = (const bf16_t*)(a.ws + WS_WIN) + (size_t)l * NINP * D + (size_t)NIN * D;
    float* ALRP = (float*)(a.ws + WS_ALRP);
    const int NGW = gridDim.x * 8;
    for (int task = blockIdx.x * 8 + wave; task < 512 * 4; task += NGW) {
        const int rb = task >> 2, kq = task & 3;
        const bf16_t* ap = AB + (size_t)(32 * rb + r32) * D + 256 * kq + 8 * hi;
        const bf16_t* bp = Wt + (size_t)r32 * D + 256 * kq + 8 * hi;
        f32x16 acc;
#pragma unroll
        for (int i = 0; i < 16; ++i) acc[i] = 0.f;
#pragma unroll
        for (int kk = 0; kk < 16; ++kk) acc = MFMA32(*(const bf16x8*)(ap + 16 * kk), *(const bf16x8*)(bp + 16 * kk), acc);
        if (r32 < 16) {
#pragma unroll
            for (int r = 0; r < 16; ++r) ALRP[((size_t)kq * M + 32 * rb + crow(r, hi)) * 16 + r32] = acc[r];
        }
    }
}

__device__ __forceinline__ s16x4 vtr(const LAS unsigned char* p) { return __builtin_bit_cast(s16x4, __builtin_amdgcn_ds_read_tr16_b64_v4i16((LAS v4i16_t*)p)); }

template <bool MASK>
__device__ __forceinline__ void sb_ew(f32x16& p, float (&om)[16], int kbase, int qpos) {
#pragma unroll
    for (int r = 0; r < 16; ++r) {
        const float x = __builtin_fmaxf(p[r], -100.0f);
        const float e = __builtin_amdgcn_exp2f(-x), b = __builtin_amdgcn_rcpf(1.0f + e), o_ = e * b;
        if (MASK) { const bool ok = (kbase + (r & 3) + 8 * (r >> 2)) < qpos; om[r] = ok ? o_ : 1.0f; p[r] = ok ? b : 0.0f; }
        else { om[r] = o_; p[r] = b; }
    }
}
__device__ __forceinline__ void sb_cum(f32x16& p, const float (&om)[16], float& run, int hi) {
#pragma unroll
    for (int g = 3; g >= 0; --g) {
        const float Go = (om[4 * g] * om[4 * g + 1]) * (om[4 * g + 2] * om[4 * g + 3]); const float Gp = __shfl_xor(Go, 32);
        const float c3 = run * (hi == 0 ? Gp : 1.0f), c2 = c3 * om[4 * g + 3], c1 = c2 * om[4 * g + 2], c0 = c1 * om[4 * g + 1];
        p[4 * g + 3] *= c3; p[4 * g + 2] *= c2; p[4 * g + 1] *= c1; p[4 * g] *= c0;
        run *= Go * Gp;
    }
}

__device__ __forceinline__ void sb_unit(const Args& a, int l, int u, LAS unsigned char* wl, int lane) {
    const int r32 = lane & 31, hi = lane >> 5;
    const bf16_t* SQ = (const bf16_t*)(a.ws + WS_SQ); const bf16_t* KB = (const bf16_t*)(a.ws + WS_KB); const bf16_t* VB = (const bf16_t*)(a.ws + WS_VB);
    bf16_t* MIX = (bf16_t*)(a.ws + WS_MIX);
    int h, qrow0, q0pos, kbrow0, ncache = 0; const float* kc = nullptr; const float* vc = nullptr;
    if (u < 4096) { const int b = u >> 10, qb = u & 127; h = (u >> 7) & 7; qrow0 = b * 4096 + 32 * qb; q0pos = 32 * qb; kbrow0 = b * 4096; }
    else { const int u2 = u - 4096, b = u2 >> 4, qb = u2 & 1; h = (u2 >> 1) & 7; qrow0 = MP + b * 64 + 32 * qb; q0pos = 1024 + 32 * qb; kbrow0 = MP + b * 64 - 1024; ncache = 16;
        kc = a.in[2] + ((size_t)(l * 8 + b) * 1024) * 512 + h * 64; vc = a.in[3] + ((size_t)(l * 8 + b) * 1024) * 512 + h * 64; }
    bf16x8 qr[4];
#pragma unroll
    for (int d0 = 0; d0 < 4; ++d0) qr[d0] = *(const bf16x8*)(SQ + (size_t)(qrow0 + r32) * 512 + h * 64 + 16 * d0 + 8 * hi);
    f32x16 o[2];
#pragma unroll
    for (int i = 0; i < 16; ++i) { o[0][i] = 0.f; o[1][i] = 0.f; }
    float carry = 1.0f;
    const int qpos = q0pos + r32;
    const LAS unsigned char* vp = wl + ((lane >> 4) & 1) * 32 + (lane & 3) * 8 + (4 * hi + ((lane & 15) >> 2)) * 64;
    const int jt0 = (q0pos + 30) >> 6;
    bf16x8 kf[2][4]; u32x4 vraw[8];
    const bf16_t* kbp = KB + (size_t)(kbrow0 + r32) * 512 + h * 64 + 8 * hi;
    const bf16_t* vbp = VB + (size_t)(kbrow0 + (lane >> 2)) * 512 + h * 64 + 8 * (lane & 3);
#define SB_LOADB(JT) do { const bf16_t* kp_ = kbp + (size_t)(JT) * (64 * 512); const bf16_t* vp_ = vbp + (size_t)(JT) * (64 * 512); \
        _Pragma("unroll") for (int hf = 0; hf < 2; ++hf) _Pragma("unroll") for (int d0 = 0; d0 < 4; ++d0) kf[hf][d0] = *(const bf16x8*)(kp_ + hf * (32 * 512) + 16 * d0); \
        _Pragma("unroll") for (int p = 0; p < 8; ++p) vraw[p] = *(const u32x4*)(vp_ + (16 * (p & 3)) * 512 + 32 * (p >> 2)); } while (0)
    if (jt0 >= ncache) SB_LOADB(jt0);
    for (int jt = jt0; jt >= 0; --jt) {
        if (jt < ncache) {
            const float* kp = kc + (size_t)(64 * jt + r32) * 512 + 8 * hi;
            {
                f32x4 kx[2][4][2];
#pragma unroll
                for (int hf = 0; hf < 2; ++hf)
#pragma unroll
                    for (int d0 = 0; d0 < 4; ++d0) { const float* p = kp + (size_t)hf * 32 * 512 + 16 * d0; kx[hf][d0][0] = *(const f32x4*)p; kx[hf][d0][1] = *(const f32x4*)(p + 4); }
                __builtin_amdgcn_sched_barrier(0);
#pragma unroll
                for (int hf = 0; hf < 2; ++hf)
#pragma unroll
                    for (int d0 = 0; d0 < 4; ++d0) kf[hf][d0] = pack8f(kx[hf][d0][0], kx[hf][d0][1]);
            }
            {
                f32x4 vx[8][2];
#pragma unroll
                for (int p = 0; p < 8; ++p) { const int row = 16 * (p & 3) + (lane >> 2), dc = 32 * (p >> 2) + 8 * (lane & 3);
                    const float* sp = vc + (size_t)(64 * jt + row) * 512 + dc; vx[p][0] = *(const f32x4*)sp; vx[p][1] = *(const f32x4*)(sp + 4); }
                __builtin_amdgcn_sched_barrier(0);
#pragma unroll
                for (int p = 0; p < 8; ++p) vraw[p] = __builtin_bit_cast(u32x4, pack8f(vx[p][0], vx[p][1]));
            }
        }
        __builtin_amdgcn_sched_barrier(0);
        const bool diag = (jt == jt0);
        const bool skip1 = diag && ((q0pos & 63) == 0);
        f32x16 p0, p1;
#pragma unroll
        for (int i = 0; i < 16; ++i) { p0[i] = 0.f; p1[i] = 0.f; }
        if (!skip1) {
#pragma unroll
            for (int d0 = 0; d0 < 4; ++d0) p1 = MFMA32(kf[1][d0], qr[d0], p1);
        }
#pragma unroll
        for (int d0 = 0; d0 < 4; ++d0) p0 = MFMA32(kf[0][d0], qr[d0], p0);
#pragma unroll
        for (int p = 0; p < 8; ++p) *(LAS u32x4*)(wl + p * 1024 + lane * 16) = vraw[p];
        __builtin_amdgcn_sched_barrier(0);
        if (jt >= 1 && jt - 1 >= ncache) SB_LOADB(jt - 1);
        __builtin_amdgcn_sched_barrier(0);
        const int kbase = 64 * jt + 4 * hi;
        float run = carry;
        if (!skip1) {
            float l1[16];
            if (diag) sb_ew<true>(p1, l1, kbase + 32, qpos); else sb_ew<false>(p1, l1, kbase + 32, qpos);
            sb_cum(p1, l1, run, hi);
        }
        {
            float l0[16];
            if (diag) sb_ew<true>(p0, l0, kbase, qpos); else sb_ew<false>(p0, l0, kbase, qpos);
            sb_cum(p0, l0, run, hi);
        }
        carry = run;
        bf16x8 pa[4];
        { u32x4 w;
          w.x = cvtpk(p0[0], p0[1]); w.y = cvtpk(p0[2], p0[3]); w.z = cvtpk(p0[4], p0[5]); w.w = cvtpk(p0[6], p0[7]); pa[0] = __builtin_bit_cast(bf16x8, w);
          w.x = cvtpk(p0[8], p0[9]); w.y = cvtpk(p0[10], p0[11]); w.z = cvtpk(p0[12], p0[13]); w.w = cvtpk(p0[14], p0[15]); pa[1] = __builtin_bit_cast(bf16x8, w);
          w.x = cvtpk(p1[0], p1[1]); w.y = cvtpk(p1[2], p1[3]); w.z = cvtpk(p1[4], p1[5]); w.w = cvtpk(p1[6], p1[7]); pa[2] = __builtin_bit_cast(bf16x8, w);
          w.x = cvtpk(p1[8], p1[9]); w.y = cvtpk(p1[10], p1[11]); w.z = cvtpk(p1[12], p1[13]); w.w = cvtpk(p1[14], p1[15]); pa[3] = __builtin_bit_cast(bf16x8, w); }
        asm volatile("s_waitcnt lgkmcnt(0)" ::: "memory");
#pragma unroll
        for (int d0 = 0; d0 < 2; ++d0)
#pragma unroll
            for (int ks = 0; ks < 2; ++ks) {
                const s16x4 lo = vtr(vp + d0 * 4096 + ks * 1024), hh = vtr(vp + d0 * 4096 + ks * 1024 + 512);
                const bf16x8 vf = (bf16x8){lo[0], lo[1], lo[2], lo[3], hh[0], hh[1], hh[2], hh[3]};
                o[d0] = MFMA32(pa[ks], vf, o[d0]);
            }
        if (!skip1) {
#pragma unroll
            for (int d0 = 0; d0 < 2; ++d0)
#pragma unroll
                for (int ks = 2; ks < 4; ++ks) {
                    const s16x4 lo = vtr(vp + d0 * 4096 + ks * 1024), hh = vtr(vp + d0 * 4096 + ks * 1024 + 512);
                    const bf16x8 vf = (bf16x8){lo[0], lo[1], lo[2], lo[3], hh[0], hh[1], hh[2], hh[3]};
                    o[d0] = MFMA32(pa[ks], vf, o[d0]);
                }
        }
        asm volatile("s_waitcnt lgkmcnt(0)" ::: "memory");
        if (__builtin_amdgcn_ballot_w64(carry >= 1e-37f) == 0ull) break;
    }
#undef SB_LOADB
    LAS bf16_t* stg = (LAS bf16_t*)wl;
#pragma unroll
    for (int r = 0; r < 16; ++r) { const int orow = crow(r, hi);
#pragma unroll
        for (int d0 = 0; d0 < 2; ++d0) stg[orow * 64 + d0 * 32 + r32] = (bf16_t)f2bf(o[d0][r]); }
    asm volatile("s_waitcnt lgkmcnt(0)" ::: "memory");
#pragma unroll
    for (int i = 0; i < 4; ++i) { const int row = i * 8 + (lane >> 3), ch = lane & 7; const u32x4 v = *(const LAS u32x4*)(stg + row * 64 + ch * 8);
        *(u32x4*)(MIX + (size_t)(qrow0 + row) * D + 512 + h * 64 + ch * 8) = v; }
    asm volatile("s_waitcnt lgkmcnt(0)" ::: "memory");
}

constexpr unsigned SB_SPLIT = 2400u;
__device__ __forceinline__ void sb_queue(const Args& a, int l, unsigned* qc, unsigned lo, unsigned hi_, LAS unsigned char* wl, int lane) {
    const int wv = __builtin_amdgcn_readfirstlane((int)(threadIdx.x >> 6));
    const unsigned v = (blockIdx.x + 224u) & 255u;
    for (int k = 0; k < 3; ++k) {
        int u; unsigned p = 0u; bool slow = false;
        if (k == 0) { if (wv == 0 && v < 128u) slow = true; else p = 2048u + v * 8u + (unsigned)wv; }
        else if (k == 1) p = v * 8u + (unsigned)wv;
        else { if (wv != 4 || v >= 128u) break; p = 2048u + v * 8u; }
        if (slow) u = 4096 + (int)v;
        else if (p < 3904u) u = (int)(p / 122u) * 128 + 6 + (int)(p % 122u);
        else { const unsigned x = p - 3904u; u = (int)(x / 6u) * 128 + (int)(x % 6u); }
        sb_unit(a, l, u, wl, lane);
    }
}

constexpr int GL_BM = 0;
constexpr int GL_ALR = 16384;
constexpr int GL_WA = GL_ALR + 4096;
constexpr int GL_BA = GL_WA + 4096;
constexpr int GL_SEG = GL_BA + 256;
constexpr int GL_KDT = 32768;
constexpr int GL_QD = GL_KDT + 9216;
constexpr int GL_VT = GL_QD + 9216;
constexpr int GL_ST = GL_VT + 18432;
constexpr int GL_OL = GL_ST + 18432;
static_assert(GL_OL + 64 * 132 * 4 <= 131072, "gla lds");

__device__ __forceinline__ void gla_b(const Args& a, int l, int row0, int h, LAS unsigned char* L, int tid) {
    LAS float* Bm = (LAS float*)(L + GL_BM); LAS float* SEG = (LAS float*)(L + GL_SEG);
    const float* ALRP = (const float*)(a.ws + WS_ALRP); const float* ssq = (const float*)(a.ws + WS_SSQ) + (size_t)(2 * l) * M;
    const int d = tid & 63, tg = __builtin_amdgcn_readfirstlane(tid >> 6);
    float wa[16];
#pragma unroll
    for (int j = 0; j < 16; ++j) wa[j] = a.in[7][((size_t)l * 16 + j) * 256 + h * 64 + d];
    const float ba = a.in[8][l * 256 + h * 64 + d];
    float bl[8]; float run = 0.f;
#pragma unroll
    for (int i = 0; i < 8; ++i) {
        const int row = row0 + 8 * tg + i;
        const float sc = rsqrtf(ssq[row] * (1.0f / D) + EPS);
        const f32x4 a0 = *(const f32x4*)(ALRP + (size_t)row * 16), a1 = *(const f32x4*)(ALRP + (size_t)row * 16 + 4), a2 = *(const f32x4*)(ALRP + (size_t)row * 16 + 8), a3 = *(const f32x4*)(ALRP + (size_t)row * 16 + 12);
        float x = (a0[0] * wa[0] + a0[1] * wa[1]) + (a0[2] * wa[2] + a0[3] * wa[3]);
        x += (a1[0] * wa[4] + a1[1] * wa[5]) + (a1[2] * wa[6] + a1[3] * wa[7]);
        x += (a2[0] * wa[8] + a2[1] * wa[9]) + (a2[2] * wa[10] + a2[3] * wa[11]);
        x += (a3[0] * wa[12] + a3[1] * wa[13]) + (a3[2] * wa[14] + a3[3] * wa[15]);
        x = x * sc + ba;
        const float ls = fminf(x, 0.f) - __logf(1.0f + __expf(-fabsf(x)));
        run += ls * (1.0f / 16.0f); bl[i] = run;
    }
    SEG[tg * 64 + d] = run;
    lds_barrier();
    float off = 0.f;
#pragma unroll
    for (int g = 0; g < 7; ++g) if (g < tg) off += SEG[g * 64 + d];
#pragma unroll
    for (int i = 0; i < 8; ++i) Bm[(8 * tg + i) * 64 + d] = bl[i] + off;
    lds_barrier();
}

__device__ __forceinline__ void gla_vt(const u32x4 v0, const u32x4 v1, LAS unsigned char* L, int tid) {
    LAS bf16_t* VT = (LAS bf16_t*)(L + GL_VT);
    const int s = tid >> 3, dg = tid & 7;
    const int sx = s ^ (8 * dg);
#pragma unroll
    for (int i = 0; i < 4; ++i) { VT[(16 * dg + 2 * i) * 72 + sx] = (bf16_t)(v0[i] & 0xffffu); VT[(16 * dg + 2 * i + 1) * 72 + sx] = (bf16_t)(v0[i] >> 16);
        VT[(16 * dg + 8 + 2 * i) * 72 + sx] = (bf16_t)(v1[i] & 0xffffu); VT[(16 * dg + 8 + 2 * i + 1) * 72 + sx] = (bf16_t)(v1[i] >> 16); }
}

__device__ __forceinline__ void gla_a_item(const Args& a, int l, int item, LAS unsigned char* L, int tid, int wave, int lane) {
    const int ch = item >> 2, h = item & 3, row0 = ch * 64;
    const u32x4 kr = *(const u32x4*)((const bf16_t*)(a.ws + WS_GK) + (size_t)(row0 + (tid >> 3)) * 256 + h * 64 + 8 * (tid & 7));
    const bf16_t* vp_ = (const bf16_t*)(a.ws + WS_GV) + (size_t)(row0 + (tid >> 3)) * 512 + h * 128 + 16 * (tid & 7);
    const u32x4 pv0 = *(const u32x4*)vp_, pv1 = *(const u32x4*)(vp_ + 8);
    gla_b(a, l, row0, h, L, tid);
    LAS float* Bm = (LAS float*)(L + GL_BM); LAS bf16_t* KDT = (LAS bf16_t*)(L + GL_KDT); LAS bf16_t* VT = (LAS bf16_t*)(L + GL_VT);
    { float* bg = a.out + O_Y + (size_t)item * 4096 + tid * 8; *(f32x4*)bg = *(const LAS f32x4*)(Bm + tid * 8); *(f32x4*)(bg + 4) = *(const LAS f32x4*)(Bm + tid * 8 + 4); }
    {
        const int s = tid >> 3, dg = tid & 7;
#pragma unroll
        for (int i = 0; i < 4; ++i) { const int d = 8 * dg + 2 * i;
            KDT[d * 72 + (s ^ (8 * dg))] = (bf16_t)f2bf(bflo(kr[i]) * __expf(Bm[63 * 64 + d] - Bm[s * 64 + d]));
            KDT[(d + 1) * 72 + (s ^ (8 * dg))] = (bf16_t)f2bf(bfhi(kr[i]) * __expf(Bm[63 * 64 + d + 1] - Bm[s * 64 + d + 1])); }
    }
    gla_vt(pv0, pv1, L, tid);
    lds_barrier();
    {
        const int r32 = lane & 31, hi = lane >> 5, di = wave >> 2, vi = wave & 3;
        f32x16 acc;
#pragma unroll
        for (int i = 0; i < 16; ++i) acc[i] = 0.f;
#pragma unroll
        for (int ks = 0; ks < 4; ++ks) { const int krow = 32 * di + r32, vrow = 32 * vi + r32;
            acc = MFMA32(*(const LAS bf16x8*)(KDT + krow * 72 + ((16 * ks + 8 * hi) ^ (8 * ((krow >> 3) & 7)))), *(const LAS bf16x8*)(VT + vrow * 72 + ((16 * ks + 8 * hi) ^ (8 * ((vrow >> 4) & 7)))), acc); }
        if (item < 1024) {
            bf16_t* U = (bf16_t*)(a.ws + WS_UST) + (size_t)item * 8192;
#pragma unroll
            for (int r = 0; r < 16; ++r) U[(32 * di + crow(r, hi)) * 128 + 32 * vi + r32] = (bf16_t)f2bf(acc[r]);
        } else {
            const float* Sin = a.in[4] + (size_t)(l * 32 + item - 1024) * 8192; float* So = a.out + O_GS + (size_t)(l * 32 + item - 1024) * 8192;
#pragma unroll
            for (int r = 0; r < 16; ++r) { const int d = 32 * di + crow(r, hi), o_ = d * 128 + 32 * vi + r32; So[o_] = __expf(Bm[63 * 64 + d]) * Sin[o_] + acc[r]; }
        }
    }
    if (tid < 64) ((float*)(a.ws + WS_DEC))[item * 64 + tid] = __expf(Bm[63 * 64 + tid]);
    lds_barrier();
}

__device__ __forceinline__ void gla_scan(const Args& a, int l, int tid) {
    unsigned* U = (unsigned*)(a.ws + WS_UST); const float* DEC = (const float*)(a.ws + WS_DEC);
    for (int e = blockIdx.x * 512 + tid; e < 65536; e += gridDim.x * 512) {
        const int bh = e >> 12, idx = e & 4095, d = idx >> 6, b = bh >> 2, h = bh & 3;
        unsigned* up = U + (size_t)(b * 256 + h) * 4096 + idx;
        const float* dp = DEC + (b * 256 + h) * 64 + d;
        float S0 = 0.f, S1 = 0.f;
#pragma unroll
        for (int hf = 0; hf < 2; ++hf) {
            unsigned tv[32]; float dv[32];
#pragma unroll
            for (int i = 0; i < 32; ++i) { tv[i] = up[(size_t)(32 * hf + i) * 16384]; dv[i] = dp[(32 * hf + i) * 256]; }
            __builtin_amdgcn_sched_barrier(0);
#pragma unroll
            for (int i = 0; i < 32; ++i) { up[(size_t)(32 * hf + i) * 16384] = cvtpk(S0, S1); S0 = S0 * dv[i] + bflo(tv[i]); S1 = S1 * dv[i] + bfhi(tv[i]); }
            __builtin_amdgcn_sched_barrier(0);
        }
        *(f32x2*)(a.out + O_GP + (size_t)(l * 16 + bh) * 8192 + 2 * idx) = (f32x2){S0, S1};
    }
}

__device__ __forceinline__ void gla_c_item(const Args& a, int l, int item, LAS unsigned char* L, int tid, int wave, int lane, bool smp = false) {
    const int ch = item >> 2, h = item & 3, row0 = ch * 64;
    LAS float* Bm = (LAS float*)(L + GL_BM); LAS bf16_t* KI = (LAS bf16_t*)(L + GL_KDT); LAS bf16_t* QD = (LAS bf16_t*)(L + GL_QD);
    LAS bf16_t* VT = (LAS bf16_t*)(L + GL_VT); LAS bf16_t* ST = (LAS bf16_t*)(L + GL_ST); LAS float* OL = (LAS float*)(L + GL_OL);
    f32x4 bm0 = {0.f, 0.f, 0.f, 0.f}, bm1 = bm0;
    if (!smp) { const float* bg = (const float*)(a.out + O_Y) + (size_t)item * 4096 + tid * 8; bm0 = *(const f32x4*)bg; bm1 = *(const f32x4*)(bg + 4); }
    const u32x4 kr = *(const u32x4*)((const bf16_t*)(a.ws + WS_GK) + (size_t)(row0 + (tid >> 3)) * 256 + h * 64 + 8 * (tid & 7));
    const u32x4 qr = *(const u32x4*)((const bf16_t*)(a.ws + WS_GQ) + (size_t)(row0 + (tid >> 3)) * 256 + h * 64 + 8 * (tid & 7));
    const bf16_t* Sg = (const bf16_t*)(a.ws + WS_UST) + (size_t)item * 8192 + (tid >> 3) * 128 + 16 * (tid & 7);
    u32x4 sg0, sg1;
    if (!smp) { sg0 = *(const u32x4*)Sg; sg1 = *(const u32x4*)(Sg + 8); }
    else {
        const float* Sf = a.in[4] + (size_t)(l * 32 + item - 1024) * 8192 + (tid >> 3) * 128 + 16 * (tid & 7);
        const f32x4 f0 = *(const f32x4*)Sf, f1 = *(const f32x4*)(Sf + 4), f2 = *(const f32x4*)(Sf + 8), f3 = *(const f32x4*)(Sf + 12);
        sg0 = (u32x4){cvtpk(f0[0], f0[1]), cvtpk(f0[2], f0[3]), cvtpk(f1[0], f1[1]), cvtpk(f1[2], f1[3])};
        sg1 = (u32x4){cvtpk(f2[0], f2[1]), cvtpk(f2[2], f2[3]), cvtpk(f3[0], f3[1]), cvtpk(f3[2], f3[3])};
    }
    const bf16_t* vp_ = (const bf16_t*)(a.ws + WS_GV) + (size_t)(row0 + (tid >> 3)) * 512 + h * 128 + 16 * (tid & 7);
    const u32x4 pv0 = *(const u32x4*)vp_, pv1 = *(const u32x4*)(vp_ + 8);
    const bf16_t* gp = (const bf16_t*)(a.ws + WS_GATE) + (size_t)(row0 + (tid >> 3)) * 512 + h * 128 + 16 * (tid & 7);
    const u32x4 g0 = *(const u32x4*)gp, g1 = *(const u32x4*)(gp + 8);
    __builtin_amdgcn_sched_barrier(0);
    if (!smp) { *(LAS f32x4*)(Bm + tid * 8) = bm0; *(LAS f32x4*)(Bm + tid * 8 + 4) = bm1; lds_barrier(); }
    else gla_b(a, l, row0, h, L, tid);
    {
        const int s = tid >> 3, dg = tid & 7;
        u32x4 ko, qo;
#pragma unroll
        for (int i = 0; i < 4; ++i) { const int d = 8 * dg + 2 * i; const float b0 = Bm[s * 64 + d], b1 = Bm[s * 64 + d + 1];
            ko[i] = cvtpk(bflo(kr[i]) * __expf(-b0), bfhi(kr[i]) * __expf(-b1)); qo[i] = cvtpk(bflo(qr[i]) * __expf(b0), bfhi(qr[i]) * __expf(b1)); }
        *(LAS u32x4*)(KI + s * 72 + 8 * dg) = ko; *(LAS u32x4*)(QD + s * 72 + 8 * dg) = qo;
#pragma unroll
        for (int j = 0; j < 4; ++j) { const unsigned w0 = j < 2 ? sg0[2 * j] : sg1[2 * j - 4], w1 = j < 2 ? sg0[2 * j + 1] : sg1[2 * j - 3];
            ST[(16 * dg + 4 * j) * 72 + (s ^ (8 * dg))] = (bf16_t)(w0 & 0xffffu); ST[(16 * dg + 4 * j + 1) * 72 + (s ^ (8 * dg))] = (bf16_t)(w0 >> 16);
            ST[(16 * dg + 4 * j + 2) * 72 + (s ^ (8 * dg))] = (bf16_t)(w1 & 0xffffu); ST[(16 * dg + 4 * j + 3) * 72 + (s ^ (8 * dg))] = (bf16_t)(w1 >> 16); }
    }
    gla_vt(pv0, pv1, L, tid);
    lds_barrier();
    {
        const int r32 = lane & 31, hi = lane >> 5, ti = wave >> 2, vi = wave & 3;
        bf16x8 qf[4];
#pragma unroll
        for (int kd = 0; kd < 4; ++kd) qf[kd] = *(const LAS bf16x8*)(QD + (32 * ti + r32) * 72 + 16 * kd + 8 * hi);
        f32x16 o;
#pragma unroll
        for (int i = 0; i < 16; ++i) o[i] = 0.f;
#pragma unroll
        for (int kd = 0; kd < 4; ++kd) { const int srow = 32 * vi + r32; o = MFMA32(qf[kd], *(const LAS bf16x8*)(ST + srow * 72 + ((16 * kd + 8 * hi) ^ (8 * ((srow >> 4) & 7)))), o); }
        const int tcol = 32 * ti + r32;
#pragma unroll
        for (int sb = 0; sb < 2; ++sb) {
            if (sb <= ti) {
                f32x16 sc;
#pragma unroll
                for (int i = 0; i < 16; ++i) sc[i] = 0.f;
#pragma unroll
                for (int kd = 0; kd < 4; ++kd) sc = MFMA32(*(const LAS bf16x8*)(KI + (32 * sb + r32) * 72 + 16 * kd + 8 * hi), qf[kd], sc);
#pragma unroll
                for (int r = 0; r < 16; ++r) { const int srow = 32 * sb + crow(r, hi); if (srow > tcol) sc[r] = 0.f; }
#pragma unroll
                for (int kq = 0; kq < 2; ++kq) {
                    u32x4 w; w.x = cvtpk(sc[8 * kq], sc[8 * kq + 1]); w.y = cvtpk(sc[8 * kq + 2], sc[8 * kq + 3]); w.z = cvtpk(sc[8 * kq + 4], sc[8 * kq + 5]); w.w = cvtpk(sc[8 * kq + 6], sc[8 * kq + 7]);
                    const int ks = 2 * sb + kq;
                    const int vrow = 32 * vi + r32, vsw = 8 * ((vrow >> 4) & 7);
                    const s16x4 lo = *(const LAS s16x4*)(VT + vrow * 72 + ((16 * ks + 4 * hi) ^ vsw)), hh = *(const LAS s16x4*)(VT + vrow * 72 + ((16 * ks + 8 + 4 * hi) ^ vsw));
                    const bf16x8 vf = (bf16x8){lo[0], lo[1], lo[2], lo[3], hh[0], hh[1], hh[2], hh[3]};
                    o = MFMA32(__builtin_bit_cast(bf16x8, w), vf, o);
                }
            }
        }
#pragma unroll
        for (int r = 0; r < 16; ++r) OL[(32 * ti + crow(r, hi)) * 132 + 32 * vi + r32] = o[r];
    }
    lds_barrier();
    {
        const int t = tid >> 3, sg = tid & 7;
        float x[16]; float q = 0.f;
#pragma unroll
        for (int j = 0; j < 4; ++j) { const f32x4 v = *(const LAS f32x4*)(OL + t * 132 + 16 * sg + 4 * j); x[4 * j] = v[0]; x[4 * j + 1] = v[1]; x[4 * j + 2] = v[2]; x[4 * j + 3] = v[3]; q += (v[0] * v[0] + v[1] * v[1]) + (v[2] * v[2] + v[3] * v[3]); }
        q += __shfl_xor(q, 1); q += __shfl_xor(q, 2); q += __shfl_xor(q, 4);
        const float rs = rsqrtf(q * (1.0f / 128.0f) + EPS);
        const float* ng = a.in[11] + l * 128 + 16 * sg;
        float gt[16];
#pragma unroll
        for (int i = 0; i < 4; ++i) { gt[2 * i] = bflo(g0[i]); gt[2 * i + 1] = bfhi(g0[i]); gt[8 + 2 * i] = bflo(g1[i]); gt[8 + 2 * i + 1] = bfhi(g1[i]); }
        float y[16];
#pragma unroll
        for (int i = 0; i < 16; ++i) { const float gv = gt[i]; const float sl = gv / (1.0f + __expf(-gv)); y[i] = x[i] * rs * ng[i] * sl; }
        u32x4 w0, w1;
#pragma unroll
        for (int i = 0; i < 4; ++i) { w0[i] = cvtpk(y[2 * i], y[2 * i + 1]); w1[i] = cvtpk(y[8 + 2 * i], y[8 + 2 * i + 1]); }
        bf16_t* mp = (bf16_t*)(a.ws + WS_MIX) + (size_t)(row0 + t) * D + h * 128 + 16 * sg;
        *(u32x4*)mp = w0; *(u32x4*)(mp + 8) = w1;
    }
    lds_barrier();
}

#define XB_TMO      128
#define XB_XCNT(j)  (256  + 64 * (j))
#define XB_XSUB(j)  (1280 + 64 * (j))
#define XB_XGEN(j)  (2304 + 64 * (j))
#define XB_TOP      3328
#define XB_TOPGEN   3392
#define XCD_BAR_WORDS 3456
#define XB_SPIN_CAP (1u << 22)
__device__ __forceinline__ unsigned xb_ld(unsigned* p)              { return __hip_atomic_load(p, __ATOMIC_RELAXED, __HIP_MEMORY_SCOPE_AGENT); }
__device__ __forceinline__ unsigned xb_add(unsigned* p, unsigned v) { return __hip_atomic_fetch_add(p, v, __ATOMIC_RELAXED, __HIP_MEMORY_SCOPE_AGENT); }
__device__ __forceinline__ unsigned xb_xcc_id() { return (unsigned)__builtin_amdgcn_s_getreg((3 << 11) | 20) & 0xFu; }
#define XB_SPIN(cond, bar) do { unsigned _sp = 0; while (cond) { __builtin_amdgcn_s_sleep(1); \
    if ((++_sp & 255u) == 0u) { if (xb_ld(&(bar)[XB_TMO])) break; if (_sp > XB_SPIN_CAP) { atomicAdd(&(bar)[XB_TMO], 1u); break; } } } } while (0)
struct XcdBarrier { unsigned* bar; unsigned x; volatile LAS unsigned* st; };
__device__ __forceinline__ XcdBarrier xcd_barrier_post(unsigned* bar, volatile LAS unsigned* st) {
    XcdBarrier b; b.bar = bar; b.x = xb_xcc_id(); b.st = st;
    if (threadIdx.x == 0) (void)xb_add(&bar[XB_XCNT(b.x)], 1u);
    return b;
}
__device__ __forceinline__ void xcd_barrier_complete(unsigned* bar, unsigned x, unsigned& nloc, unsigned& nx) {
    const unsigned G = gridDim.x * gridDim.y * gridDim.z;
    unsigned sum, cnt, mine, sp = 0u;
    for (;;) {
        sum = 0u; cnt = 0u; mine = 0u;
#pragma unroll
        for (unsigned j = 0; j < 16; ++j) { const unsigned c = xb_ld(&bar[XB_XCNT(j)]); sum += c; cnt += (c > 0u) ? 1u : 0u; mine = (j == x) ? c : mine; }
        if (sum == G) break;
        __builtin_amdgcn_s_sleep(1);
        if ((++sp & 255u) == 0u) { if (xb_ld(&bar[XB_TMO])) break; if (sp > XB_SPIN_CAP) { atomicAdd(&bar[XB_TMO], 1u); break; } }
    }
    nloc = mine > 0u ? mine : 1u; nx = cnt > 0u ? cnt : 1u;
}
__device__ __forceinline__ void xcd_barrier(const XcdBarrier& b) {
    asm volatile("s_waitcnt vmcnt(0)" ::: "memory");
    __syncthreads();
    if (threadIdx.x == 0) {
        unsigned* bar = b.bar;
        __builtin_amdgcn_s_waitcnt(0);
        unsigned nloc = b.st[0], nx = b.st[1];
        if (nloc == 0u) { xcd_barrier_complete(bar, b.x, nloc, nx); b.st[0] = nloc; b.st[1] = nx; }
        const unsigned old = xb_add(&bar[XB_XSUB(b.x)], 1u);
        const unsigned gen = old / nloc;
        if (old + 1u == (gen + 1u) * nloc) {
            __builtin_amdgcn_fence(__ATOMIC_RELEASE, "agent");
            asm volatile("s_waitcnt vmcnt(0)" ::: "memory");
            const unsigned og = xb_add(&bar[XB_TOP], 1u);
            const unsigned tg = og / nx;
            if (og + 1u == (tg + 1u) * nx) xb_add(&bar[XB_TOPGEN], 1u);
            else XB_SPIN(xb_ld(&bar[XB_TOPGEN]) == tg, bar);
            __builtin_amdgcn_fence(__ATOMIC_ACQUIRE, "agent");
            xb_add(&bar[XB_XGEN(b.x)], 1u);
            asm volatile("s_waitcnt vmcnt(0)" ::: "memory");
        } else {
            XB_SPIN(xb_ld(&bar[XB_XGEN(b.x)]) == gen, bar);
            __builtin_amdgcn_fence(__ATOMIC_ACQUIRE, "agent");
            asm volatile("s_waitcnt vmcnt(0)" ::: "memory");
        }
    }
    __syncthreads();
}

__device__ __forceinline__ int fresh_tid() { int t = threadIdx.x; asm volatile("" : "+v"(t)); return t; }
#define FRESH() const int tid = fresh_tid(), lane = tid & 63, wave = __builtin_amdgcn_readfirstlane(tid >> 6)
__global__ void __launch_bounds__(512, 2) fwd_kernel(Args a) {
    extern __shared__ __attribute__((aligned(16))) unsigned char lds_raw[];
    cg::grid_group grid = cg::this_grid();
    LAS unsigned char* L = (LAS unsigned char*)lds_raw;
    const int G = gridDim.x;
    unsigned char* ws = a.ws;
    if (a.out == nullptr) grid.sync();
    if (threadIdx.x < 16) ((LAS unsigned*)(L + 131072))[threadIdx.x] = 0u;
    __syncthreads();
    (void)xcd_barrier_post((unsigned*)ws, (volatile LAS unsigned*)(L + 131072));
#define GRID_BAR() do { XcdBarrier b_; b_.bar = (unsigned*)a.ws; b_.x = xb_xcc_id(); b_.st = (volatile LAS unsigned*)(L + 131072); xcd_barrier(b_); } while (0)

    for (int rep = 0; rep < REP_PRO; ++rep) { FRESH(); prologue(a, L, tid, wave, lane); }
    GRID_BAR();

#pragma nounroll
    for (int l = 0; l < 2; ++l) {
        float* ssq = (float*)(ws + WS_SSQ);
        bf16_t* AB = (bf16_t*)(ws + WS_AB);
        for (int rep = 0; rep < REP_SMALL; ++rep) {
        { SEpiAlr EA{(float*)(ws + WS_ALRP)}; small_gemm<4, false, SEpiAlr>(L, (const void*)AB, D, (const bf16_t*)(ws + WS_WIN) + (size_t)l * NINP * D, 1, EA, fresh_tid(), 512); }
        { SEpiIn E{l, ws, a.out + O_KS + (size_t)l * MS * 512, a.out + O_VS + (size_t)l * MS * 512, a.in[9] + l * 64, a.in[10] + l * 64};
          small_gemm<2, true, SEpiIn>(L, l == 0 ? (const void*)a.in[1] : (const void*)(a.out + O_Y + (size_t)MP * D), D, (const bf16_t*)(ws + WS_WIN) + (size_t)l * NINP * D, 49, E, fresh_tid()); }
        }
        {
            pg8::Gemm g{AB, (const bf16_t*)(ws + WS_WIN) + (size_t)l * NINP * D, M, NIN, D};
            pg8::StaticOrder S; S.init(MP, NIN, G, (int)blockIdx.x);
            pg8::EpiIn E{ssq + (size_t)(2 * l) * M, (bf16_t*)(ws + WS_GQ), (bf16_t*)(ws + WS_GK), (bf16_t*)(ws + WS_GV), (bf16_t*)(ws + WS_GATE), (bf16_t*)(ws + WS_SQ), (bf16_t*)(ws + WS_KB), (bf16_t*)(ws + WS_VB),
                          a.out + O_KP + (size_t)l * MP * 512, a.out + O_VP + (size_t)l * MP * 512, a.out + O_KS + (size_t)l * MS * 512, a.out + O_VS + (size_t)l * MS * 512, a.in[9] + l * 64, a.in[10] + l * 64};
            for (int rep = 0; rep < REP_GEMM; ++rep) pg8::gemm_phase<pg8::EpiIn, pg8::StaticOrder, true, true>(L, g, S, E, fresh_tid());
        }
        GRID_BAR();
        { FRESH(); (void)tid; sb_queue(a, l, (unsigned*)ws + 4096 + 64 * (2 * l), 0u, 4224u, L + wave * 8192, lane); }
        __syncthreads();
        { FRESH(); for (int it = blockIdx.x; it < 1024; it += G) gla_a_item(a, l, it, L, tid, wave, lane); }
        GRID_BAR();
        { FRESH(); gla_scan(a, l, tid);
          if (blockIdx.x >= 128 && blockIdx.x < 160) gla_a_item(a, l, 1024 + (int)blockIdx.x - 128, L, tid, wave, lane);
          else if (blockIdx.x >= 160 && blockIdx.x < 192) gla_c_item(a, l, 1024 + (int)blockIdx.x - 160, L, tid, wave, lane, true); }
        GRID_BAR();
        { FRESH(); for (int it = blockIdx.x; it < 1024; it += G) gla_c_item(a, l, it, L, tid, wave, lane); }
        GRID_BAR();
        {
            pg8::Gemm g{(const bf16_t*)(ws + WS_MIX), (const bf16_t*)(ws + WS_WOUT) + (size_t)l * D * D, M, D, D};
            { SEpiRes E2{l == 0 ? a.in[1] : a.out + O_Y + (size_t)MP * D, a.out + O_Y + (size_t)MP * D};
              small_gemm<8, false, SEpiRes>(L, (const void*)((const bf16_t*)(ws + WS_MIX) + (size_t)MP * D), D, (const bf16_t*)(ws + WS_WOUT) + (size_t)l * D * D, 16, E2, fresh_tid()); }
            pg8::StaticOrder S; S.init(MP, D, G, (int)blockIdx.x);
            pg8::EpiRes E{l == 0 ? a.in[0] : (const float*)nullptr, AB, (float*)nullptr, AB, ssq + (size_t)(2 * l + 1) * M};
            pg8::gemm_phase<pg8::EpiRes, pg8::StaticOrder, true, true>(L, g, S, E, fresh_tid());
        }
        GRID_BAR();
        {
            pg8::Gemm g{AB, (const bf16_t*)(ws + WS_WUP) + (size_t)l * FF * D, M, FF, D};
            for (int rep = 0; rep < REP_SMALL; ++rep) { SEpiUp E2{(bf16_t*)(ws + WS_U) + (size_t)MP * FF};
              small_gemm<2, true, SEpiUp>(L, (const void*)(a.out + O_Y + (size_t)MP * D), D, (const bf16_t*)(ws + WS_WUP) + (size_t)l * FF * D, 64, E2, fresh_tid()); }
            pg8::StaticOrder S; S.init(MP, FF, G, (int)blockIdx.x);
            pg8::EpiUp E{ssq + (size_t)(2 * l + 1) * M, (bf16_t*)(ws + WS_U)};
            for (int rep = 0; rep < REP_GEMM; ++rep) pg8::gemm_phase<pg8::EpiUp, pg8::StaticOrder, true, true>(L, g, S, E, fresh_tid());
        }
        GRID_BAR();
        {
            pg8::Gemm g{(const bf16_t*)(ws + WS_U), (const bf16_t*)(ws + WS_WDN) + (size_t)l * D * FF, M, D, FF};
            { SEpiRes E2{a.out + O_Y + (size_t)MP * D, a.out + O_Y + (size_t)MP * D};
              small_gemm<8, false, SEpiRes>(L, (const void*)((const bf16_t*)(ws + WS_U) + (size_t)MP * FF), FF, (const bf16_t*)(ws + WS_WDN) + (size_t)l * D * FF, 16, E2, fresh_tid()); }
            pg8::StaticOrder S; S.init(MP, D, G, (int)blockIdx.x);
            pg8::EpiRes E{(const float*)nullptr, AB, l == 0 ? (float*)nullptr : a.out + O_Y, l == 0 ? AB : (bf16_t*)nullptr, ssq + (size_t)(l == 0 ? 2 : 3) * M};
            pg8::gemm_phase<pg8::EpiRes, pg8::StaticOrder, true, true>(L, g, S, E, fresh_tid());
        }
        if (l == 0) GRID_BAR();
    }
}

extern "C" void kernel_launch(void* const* d_in, const int* in_sizes, int n_in, void* d_out, int out_size, void* d_ws, size_t ws_size, hipStream_t stream) {
    static int grid = 0;
    if (grid == 0) {
        if (n_in != 16 || (size_t)out_size != O_END || ws_size < WS_END) { fprintf(stderr, "kernel_launch: unexpected shapes (n_in %d out %d ws %zu)\n", n_in, out_size, ws_size); grid = -1; return; }
        int dev = 0, cus = 0, per_cu = 0;
        (void)hipGetDevice(&dev);
        (void)hipDeviceGetAttribute(&cus, hipDeviceAttributeMultiprocessorCount, dev);
        if (hipFuncSetAttribute((const void*)fwd_kernel, hipFuncAttributeMaxDynamicSharedMemorySize, LDS_BYTES) != hipSuccess) { fprintf(stderr, "kernel_launch: hipFuncSetAttribute failed\n"); grid = -1; return; }
        (void)hipOccupancyMaxActiveBlocksPerMultiprocessor(&per_cu, (const void*)fwd_kernel, 512, LDS_BYTES);
        (void)hipGetLastError();
        grid = cus > 0 ? cus : 256;
        if (per_cu < 1) fprintf(stderr, "kernel_launch: occupancy query says %d blocks per CU\n", per_cu);
    }
    if (grid < 0) return;
    if (hipMemsetAsync(d_ws, 0, 32768, stream) != hipSuccess) { fprintf(stderr, "kernel_launch: memset failed\n"); return; }
    Args a{};
    for (int i = 0; i < 16; ++i) a.in[i] = (const float*)d_in[i];
    a.out = (float*)d_out; a.ws = (unsigned char*)d_ws;
    void* args[] = {&a};
    hipError_t e = hipLaunchCooperativeKernel((const void*)fwd_kernel, dim3(grid), dim3(512), args, LDS_BYTES, stream);
    if (e != hipSuccess) fprintf(stderr, "kernel_launch: cooperative launch failed: %s (grid %d)\n", hipGetErrorString(e), grid);
}
```

```cpp
#include <hip/hip_runtime.h>
#include <hip/hip_cooperative_groups.h>
#include <cstdio>
#include <cstdint>
namespace cg = cooperative_groups;

#define LAS __attribute__((address_space(3)))
typedef unsigned short bf16_t;
typedef short bf16x8 __attribute__((ext_vector_type(8)));
typedef short s16x4 __attribute__((ext_vector_type(4)));
typedef float f32x4 __attribute__((ext_vector_type(4)));
typedef float f32x2 __attribute__((ext_vector_type(2)));
typedef float f32x16 __attribute__((ext_vector_type(16)));
typedef unsigned u32x4 __attribute__((ext_vector_type(4)));
typedef unsigned u32x2 __attribute__((ext_vector_type(2)));
typedef __bf16 bf16x2_t __attribute__((ext_vector_type(2)));
typedef short v4i16_t __attribute__((ext_vector_type(4)));

constexpr int MP = 16384, MS = 512, M = MP + MS;
constexpr int D = 1024, FF = 4096, NIN = 3072, NINP = 3104;
constexpr float EPS = 1e-6f;
constexpr float LOG2E = 1.4426950408889634f;
constexpr float QSCALE = 0.125f * LOG2E;

constexpr size_t MiB = 1u << 20;
constexpr size_t WS_SSQ = 1 * MiB;
constexpr size_t WS_DEC = 1 * MiB + 512 * 1024;
constexpr size_t WS_ALRP = 2 * MiB;
constexpr size_t WS_WIN = 7 * MiB;
constexpr size_t WS_WOUT = 20 * MiB;
constexpr size_t WS_WUP = 24 * MiB;
constexpr size_t WS_WDN = 40 * MiB;
constexpr size_t WS_AB = 56 * MiB;
constexpr size_t WS_MIX = 89 * MiB;
constexpr size_t WS_U = 122 * MiB;
constexpr size_t WS_GQ = WS_U;
constexpr size_t WS_GK = WS_GQ + (size_t)M * 256 * 2;
constexpr size_t WS_GV = WS_GK + (size_t)M * 256 * 2;
constexpr size_t WS_GATE = WS_GV + (size_t)M * 512 * 2;
constexpr size_t WS_SQ = WS_GATE + (size_t)M * 512 * 2;
constexpr size_t WS_KB = WS_SQ + (size_t)M * 512 * 2;
constexpr size_t WS_VB = WS_KB + (size_t)M * 512 * 2;
constexpr size_t WS_UST = WS_VB + (size_t)M * 512 * 2;
constexpr size_t WS_END = WS_U + (size_t)M * FF * 2;
static_assert(WS_UST + (size_t)1056 * 8192 * 4 <= WS_END, "overlay");
static_assert(WS_END <= 256 * MiB, "ws");

constexpr size_t O_Y = 0;
constexpr size_t O_KP = (size_t)M * D;
constexpr size_t O_VP = O_KP + (size_t)2 * MP * 512;
constexpr size_t O_GP = O_VP + (size_t)2 * MP * 512;
constexpr size_t O_KS = O_GP + (size_t)2 * 16 * 8192;
constexpr size_t O_VS = O_KS + (size_t)2 * MS * 512;
constexpr size_t O_GS = O_VS + (size_t)2 * MS * 512;
constexpr size_t O_END = O_GS + (size_t)2 * 32 * 8192;

constexpr int LDS_BYTES = 147456;
#ifndef REP_GEMM
#define REP_GEMM 1
#endif
#ifndef REP_MIX
#define REP_MIX 1
#endif
#ifndef REP_PRO
#define REP_PRO 1
#endif
#ifndef REP_SMALL
#define REP_SMALL 1
#endif

struct Args { const float* in[16]; float* out; unsigned char* ws; };

__device__ __forceinline__ unsigned cvtpk(float lo, float hi) { f32x2 v = {lo, hi}; bf16x2_t b = __builtin_convertvector(v, bf16x2_t); return __builtin_bit_cast(unsigned, b); }
__device__ __forceinline__ unsigned f2bf(float f) { unsigned u = __builtin_bit_cast(unsigned, f); return (u + 0x7fffu + ((u >> 16) & 1u)) >> 16; }
__device__ __forceinline__ float bflo(unsigned w) { return __builtin_bit_cast(float, w << 16); }
__device__ __forceinline__ float bfhi(unsigned w) { return __builtin_bit_cast(float, w & 0xffff0000u); }
__device__ __forceinline__ int crow(int r, int hi) { return (r & 3) + 8 * (r >> 2) + 4 * hi; }
__device__ __forceinline__ float wave_sum(float v) {
#pragma unroll
    for (int o = 1; o < 64; o <<= 1) v += __shfl_xor(v, o);
    return v;
}
__device__ __forceinline__ bf16x8 pack8f(const f32x4 a, const f32x4 b) { u32x4 w; w.x = cvtpk(a[0], a[1]); w.y = cvtpk(a[2], a[3]); w.z = cvtpk(b[0], b[1]); w.w = cvtpk(b[2], b[3]); return __builtin_bit_cast(bf16x8, w); }
__device__ __forceinline__ void lds_barrier() { asm volatile("s_waitcnt lgkmcnt(0)\n\ts_barrier" ::: "memory"); }
#define MFMA32(a, b, c) __builtin_amdgcn_mfma_f32_32x32x16_bf16((a), (b), (c), 0, 0, 0)

namespace pg8 {
constexpr int BM = 256, BK = 64, HALF = 128, HTB = HALF * BK * 2, STAGE_BYTES = 8 * HTB, NXCD = 8, WGM = 8;
__host__ __device__ __forceinline__ int lds_byte(int r, int c) { const int st = (r >> 4) * 2 + (c >> 5), rr = r & 15, cc = c & 31, ob = rr * 64 + cc * 2; return st * 1024 + (ob ^ (((ob >> 9) & 1) << 5)); }
__host__ __device__ __forceinline__ void stage_rc(int b, int& R, int& C) { const int st = b / 1024, sb = b % 1024, swz = sb ^ (((sb >> 9) & 1) << 5); R = (st >> 1) * 16 + swz / 64; C = (st & 1) * 32 + (swz % 64) / 2; }
__host__ __device__ __forceinline__ int perm32(int rho) { const int n = rho >> 4, i = rho & 15; return 8 * (i >> 2) + 4 * n + (i & 3); }
struct Unit { int pm, pn; };
struct Gemm { const bf16_t* A; const bf16_t* Bt; int M, N, K; };
struct StaticOrder {
    int nM, nN, nwg, G, c;
    __host__ __device__ void init(int M_, int N_, int G_, int c_) { nM = M_ / BM; nN = N_ / BM; nwg = nM * nN; G = G_; c = c_; }
    __host__ __device__ bool next(int i, Unit& u) const {
        const long Lx = (long)i * G + c; if (Lx >= nwg) return false;
        int wgid = (int)Lx; { const int q = nwg / NXCD, r = nwg % NXCD, xcd = wgid % NXCD, off = wgid / NXCD; wgid = (xcd < r ? xcd * (q + 1) : r * (q + 1) + (xcd - r) * q) + off; }
        const int nig = WGM * nN, gid = wgid / nig, fm = gid * WGM, gsz = (nM - fm) < WGM ? (nM - fm) : WGM;
        u.pm = fm + ((wgid % nig) % gsz); u.pn = (wgid % nig) / gsz; return true;
    }
    __device__ __forceinline__ void a_ready(const Unit&) const {}
    __device__ __forceinline__ void done(const Unit&) const {}
};

template <class Epi, class Sched, bool ALIGN_EPI = false, bool SP2 = false>
__device__ __forceinline__ void gemm_phase(LAS unsigned char* lds, const Gemm g, const Sched& S, const Epi& E, const int tid) {
    const int wid = __builtin_amdgcn_readfirstlane(tid >> 6), lane = tid & 63, wr = wid >> 2, wc = wid & 3, fr = lane & 15, fq = lane >> 4;
    const int K = g.K, nt = K / BK;
    unsigned voffA[2], voffB[2];
#pragma unroll
    for (int i = 0; i < 2; ++i) { int R, C; stage_rc(tid * 16 + i * 8192, R, C); const int Rb = Epi::PERM ? ((R & ~31) + perm32(R & 31)) : R;
        voffA[i] = (unsigned)(R * K + C) * 2u; voffB[i] = (unsigned)(Rb * K + C) * 2u; }
    const size_t kstep = (size_t)(BK * 2);
    const size_t hstep = (size_t)HALF * K * 2;
    const size_t tstep = 2 * hstep;
    const unsigned ldsw = (unsigned)wid * 1024u;
    const int aoff = lds_byte(wr * 64 + fr, fq * 8), boff = lds_byte(wc * 32 + fr, fq * 8);
#define PG8_SA(b, h) (((b) * 2 + (h)) * HTB)
#define PG8_SB(b, h) ((4 + (b) * 2 + (h)) * HTB)
#define PG8_STAGE(bufoff, gbase, voff) do { _Pragma("unroll") for (int _i = 0; _i < 2; ++_i) \
        __builtin_amdgcn_global_load_lds((const unsigned*)((const char*)(gbase) + (voff)[_i]), (LAS unsigned*)(lds + (bufoff) + ldsw + _i * 8192), 16, 0, 0); } while (0)
#define PG8_LDA(dst, b, h) do { _Pragma("unroll") for (int m = 0; m < 4; ++m) _Pragma("unroll") for (int k = 0; k < 2; ++k) dst[m][k] = *(const LAS bf16x8*)(lds + PG8_SA(b, h) + aoff + m * 2048 + k * 1024); } while (0)
#define PG8_LDB(dst, b, h) do { _Pragma("unroll") for (int n = 0; n < 2; ++n) _Pragma("unroll") for (int k = 0; k < 2; ++k) dst[n][k] = *(const LAS bf16x8*)(lds + PG8_SB(b, h) + boff + n * 2048 + k * 1024); } while (0)
#define PG8_MMA(ai, bj, At, Bt) do { __builtin_amdgcn_s_setprio(1); _Pragma("unroll") for (int m = 0; m < 4; ++m) _Pragma("unroll") for (int n = 0; n < 2; ++n) _Pragma("unroll") for (int k = 0; k < 2; ++k) \
        acc[ai][bj][m][n] = __builtin_amdgcn_mfma_f32_16x16x32_bf16(Bt[n][k], At[m][k], acc[ai][bj][m][n], 0, 0, 0); __builtin_amdgcn_s_setprio(0); } while (0)
#define PG8_WAIT_V(n) asm volatile("s_waitcnt vmcnt(" #n ")" ::: "memory")
#define PG8_WAIT_L(n) asm volatile("s_waitcnt lgkmcnt(" #n ")" ::: "memory")
#define PG8_BAR __builtin_amdgcn_s_barrier()
#define PG8_SCHED __builtin_amdgcn_sched_barrier(0)
    Unit cur, nxt; int ui = 0;
    if (!S.next(0, cur)) return;
    f32x4 acc[2][2][4][2];
#pragma unroll
    for (int a = 0; a < 2; ++a)
#pragma unroll
        for (int b = 0; b < 2; ++b)
#pragma unroll
            for (int m = 0; m < 4; ++m)
#pragma unroll
                for (int n = 0; n < 2; ++n) acc[a][b][m][n] = (f32x4){0.f, 0.f, 0.f, 0.f};
    bf16x8 At[4][2], B0[2][2], B1[2][2];
    const char* cA = (const char*)g.A + (size_t)cur.pm * tstep; const char* cB = (const char*)g.Bt + (size_t)cur.pn * tstep;
    S.a_ready(cur);
    if constexpr (SP2) {
        PG8_STAGE(PG8_SB(0, 0), cB, voffB); PG8_STAGE(PG8_SB(0, 1), cB + hstep, voffB); PG8_STAGE(PG8_SA(0, 0), cA, voffA); PG8_STAGE(PG8_SA(0, 1), cA + hstep, voffA);
        if (wr == 1) PG8_BAR;
        PG8_WAIT_V(2); PG8_BAR;
        PG8_STAGE(PG8_SB(1, 0), cB + kstep, voffB); PG8_STAGE(PG8_SA(1, 0), cA + kstep, voffA); PG8_STAGE(PG8_SB(1, 1), cB + hstep + kstep, voffB);
        PG8_WAIT_V(6); PG8_BAR;
    } else {
        PG8_STAGE(PG8_SB(0, 0), cB, voffB); PG8_STAGE(PG8_SA(0, 0), cA, voffA); PG8_STAGE(PG8_SB(0, 1), cB + hstep, voffB); PG8_STAGE(PG8_SA(0, 1), cA + hstep, voffA);
        if (wr == 1) PG8_BAR;
        PG8_WAIT_V(4); PG8_BAR;
        PG8_STAGE(PG8_SB(1, 0), cB + kstep, voffB); PG8_STAGE(PG8_SA(1, 0), cA + kstep, voffA); PG8_STAGE(PG8_SB(1, 1), cB + hstep + kstep, voffB);
        PG8_WAIT_V(6); PG8_BAR;
    }
    for (;;) {
        const bool has_next = S.next(ui + 1, nxt);
        const char* nA = has_next ? (const char*)g.A + (size_t)nxt.pm * tstep : cA; const char* nB = has_next ? (const char*)g.Bt + (size_t)nxt.pn * tstep : cB;
        for (int t = 0; t < nt; t += 2) {
            const bool last = (t == nt - 2);
            const char* a1 = cA + (size_t)(t + 1) * kstep;
            const char* a2 = last ? nA : cA + (size_t)(t + 2) * kstep; const char* b2 = last ? nB : cB + (size_t)(t + 2) * kstep;
            const char* a3 = a2 + kstep; const char* b3 = b2 + kstep;
            if (last && has_next) S.a_ready(nxt);
            if constexpr (SP2) {
            PG8_LDB(B0, 0, 0); PG8_LDB(B1, 0, 1); PG8_SCHED; PG8_LDA(At, 0, 0); PG8_STAGE(PG8_SA(1, 1), a1 + hstep, voffA);
            PG8_WAIT_V(8); PG8_WAIT_L(0); PG8_BAR; PG8_MMA(0, 0, At, B0); PG8_MMA(0, 1, At, B1); PG8_BAR; PG8_SCHED;
            PG8_LDA(At, 0, 1); PG8_STAGE(PG8_SB(0, 0), b2, voffB); PG8_STAGE(PG8_SB(0, 1), b2 + hstep, voffB); PG8_STAGE(PG8_SA(0, 0), a2, voffA);
            PG8_WAIT_V(8); PG8_WAIT_L(0); PG8_BAR; PG8_MMA(1, 0, At, B0); PG8_MMA(1, 1, At, B1); PG8_BAR; PG8_SCHED;
            PG8_LDB(B0, 1, 0); PG8_LDB(B1, 1, 1); PG8_SCHED; PG8_LDA(At, 1, 0); PG8_STAGE(PG8_SA(0, 1), a2 + hstep, voffA);
            PG8_WAIT_V(8); PG8_WAIT_L(0); PG8_BAR; PG8_MMA(0, 0, At, B0); PG8_MMA(0, 1, At, B1); PG8_BAR; PG8_SCHED;
            PG8_LDA(At, 1, 1); PG8_STAGE(PG8_SB(1, 0), b3, voffB); PG8_STAGE(PG8_SB(1, 1), b3 + hstep, voffB); PG8_STAGE(PG8_SA(1, 0), a3, voffA);
            PG8_WAIT_V(8); PG8_WAIT_L(0); PG8_BAR; PG8_MMA(1, 0, At, B0); PG8_MMA(1, 1, At, B1); PG8_BAR; PG8_SCHED;
            } else {
            PG8_LDB(B0, 0, 0); PG8_SCHED; PG8_LDA(At, 0, 0); PG8_STAGE(PG8_SA(1, 1), a1 + hstep, voffA);
            PG8_WAIT_L(8); PG8_BAR; PG8_WAIT_L(0); PG8_MMA(0, 0, At, B0); PG8_BAR; PG8_SCHED;
            PG8_LDB(B1, 0, 1); PG8_STAGE(PG8_SB(0, 0), b2, voffB);
            PG8_BAR; PG8_WAIT_L(0); PG8_MMA(0, 1, At, B1); PG8_BAR;
            PG8_LDA(At, 0, 1); PG8_STAGE(PG8_SA(0, 0), a2, voffA);
            PG8_BAR; PG8_WAIT_L(0); PG8_MMA(1, 0, At, B0); PG8_BAR; PG8_SCHED;
            PG8_STAGE(PG8_SB(0, 1), b2 + hstep, voffB);
            PG8_WAIT_V(6); PG8_BAR; PG8_MMA(1, 1, At, B1); PG8_BAR;
            PG8_LDB(B0, 1, 0); PG8_SCHED; PG8_LDA(At, 1, 0); PG8_STAGE(PG8_SA(0, 1), a2 + hstep, voffA);
            PG8_WAIT_L(8); PG8_BAR; PG8_WAIT_L(0); PG8_MMA(0, 0, At, B0); PG8_BAR; PG8_SCHED;
            PG8_LDB(B1, 1, 1); PG8_STAGE(PG8_SB(1, 0), b3, voffB);
            PG8_BAR; PG8_WAIT_L(0); PG8_MMA(0, 1, At, B1); PG8_BAR;
            PG8_LDA(At, 1, 1); PG8_STAGE(PG8_SA(1, 0), a3, voffA);
            PG8_BAR; PG8_WAIT_L(0); PG8_MMA(1, 0, At, B0); PG8_BAR; PG8_SCHED;
            PG8_STAGE(PG8_SB(1, 1), b3 + hstep, voffB);
            PG8_WAIT_V(6); PG8_BAR; PG8_MMA(1, 1, At, B1); PG8_BAR;
            }
        }
        if constexpr (ALIGN_EPI) { if (wr == 0) PG8_BAR; }
        E(acc, cur, wr, wc, fr, fq); S.done(cur);
        if (!has_next) break;
#pragma unroll
        for (int a = 0; a < 2; ++a)
#pragma unroll
            for (int b = 0; b < 2; ++b)
#pragma unroll
                for (int m = 0; m < 4; ++m)
#pragma unroll
                    for (int n = 0; n < 2; ++n) acc[a][b][m][n] = (f32x4){0.f, 0.f, 0.f, 0.f};
        cur = nxt; cA = nA; cB = nB; ++ui;
        if constexpr (ALIGN_EPI) { if (wr == 1) PG8_BAR; }
    }
    PG8_WAIT_V(0);
    if constexpr (!ALIGN_EPI) { if (wr == 0) PG8_BAR; }
    PG8_BAR;
#undef PG8_SA
#undef PG8_SB
#undef PG8_STAGE
#undef PG8_LDA
#undef PG8_LDB
#undef PG8_MMA
#undef PG8_WAIT_V
#undef PG8_WAIT_L
#undef PG8_BAR
#undef PG8_SCHED
}


struct EpiIn {
    static constexpr bool PERM = true;
    const float* ssq; bf16_t *GQ, *GK, *GV, *GATE, *SQ, *KB, *VB; float *Kp, *Vp, *Ks, *Vs; const float *qg, *kg;
    __device__ __forceinline__ void operator()(const f32x4 (&acc)[2][2][4][2], const Unit& u, int wr, int wc, int fr, int fq) const {
        const int pn = u.pn;
        float sv[2][4];
#pragma unroll
        for (int ai = 0; ai < 2; ++ai)
#pragma unroll
            for (int m = 0; m < 4; ++m) sv[ai][m] = ssq[u.pm * BM + ai * HALF + wr * 64 + m * 16 + fr];
        f32x4 gg[2][2];
        { const float* gp0 = (pn < 8) ? qg : kg;
#pragma unroll
          for (int bj = 0; bj < 2; ++bj) { gg[bj][0] = *(const f32x4*)(gp0 + 32 * bj + 8 * fq); gg[bj][1] = *(const f32x4*)(gp0 + 32 * bj + 8 * fq + 4); } }
        __builtin_amdgcn_sched_barrier(0);
#pragma unroll
        for (int ai = 0; ai < 2; ++ai)
#pragma unroll
            for (int m = 0; m < 4; ++m) {
                const int row = u.pm * BM + ai * HALF + wr * 64 + m * 16 + fr;
                const float s = rsqrtf(sv[ai][m] * (1.0f / D) + EPS);
                f32x4 v[2][2];
#pragma unroll
                for (int bj = 0; bj < 2; ++bj)
#pragma unroll
                    for (int n = 0; n < 2; ++n) v[bj][n] = acc[ai][bj][m][n] * s;
                if (pn < 6) {
                    bf16_t* base; int pitch, c0; float sc = 1.f;
                    if (pn == 0) { base = GQ; pitch = 256; c0 = 0; sc = 0.125f; }
                    else if (pn == 1) { base = GK; pitch = 256; c0 = 0; }
                    else if (pn < 4) { base = GV; pitch = 512; c0 = (pn - 2) * 256; }
                    else { base = GATE; pitch = 512; c0 = (pn - 4) * 256; }
#pragma unroll
                    for (int bj = 0; bj < 2; ++bj) {
                        const f32x4 a = v[bj][0] * sc, b = v[bj][1] * sc;
                        u32x4 w; w.x = cvtpk(a[0], a[1]); w.y = cvtpk(a[2], a[3]); w.z = cvtpk(b[0], b[1]); w.w = cvtpk(b[2], b[3]);
                        *(u32x4*)(base + (size_t)row * pitch + c0 + bj * HALF + wc * 32 + 8 * fq) = w;
                    }
                } else if (pn < 10) {
                    float q = 0.f;
#pragma unroll
                    for (int bj = 0; bj < 2; ++bj)
#pragma unroll
                        for (int n = 0; n < 2; ++n) { const f32x4 x = v[bj][n]; q += (x[0] * x[0] + x[1] * x[1]) + (x[2] * x[2] + x[3] * x[3]); }
                    q += __shfl_xor(q, 16); q += __shfl_xor(q, 32);
                    const float rs = rsqrtf(q * (1.0f / 64.0f) + EPS);
                    const bool isq = pn < 8;
                    const float mul = isq ? rs * QSCALE : rs;
                    const size_t orow = (u.pm < 64) ? (size_t)row : (size_t)(row - MP);
                    float* kout = (u.pm < 64) ? Kp : Ks;
#pragma unroll
                    for (int bj = 0; bj < 2; ++bj) {
                        const int j = 32 * bj + 8 * fq;
                        const int col = (pn & 1) * 256 + 64 * wc + j;
                        const f32x4 g0 = gg[bj][0], g1 = gg[bj][1];
                        const f32x4 a = v[bj][0] * g0 * mul, b = v[bj][1] * g1 * mul;
                        u32x4 w; w.x = cvtpk(a[0], a[1]); w.y = cvtpk(a[2], a[3]); w.z = cvtpk(b[0], b[1]); w.w = cvtpk(b[2], b[3]);
                        if (isq) { *(u32x4*)(SQ + (size_t)row * 512 + col) = w; }
                        else { *(u32x4*)(KB + (size_t)row * 512 + col) = w; __builtin_nontemporal_store(a, (f32x4*)(kout + orow * 512 + col)); __builtin_nontemporal_store(b, (f32x4*)(kout + orow * 512 + col + 4)); }
                    }
                } else {
                    const size_t orow = (u.pm < 64) ? (size_t)row : (size_t)(row - MP);
                    float* vout = (u.pm < 64) ? Vp : Vs;
#pragma unroll
                    for (int bj = 0; bj < 2; ++bj) {
                        const int col = (pn - 10) * 256 + bj * HALF + wc * 32 + 8 * fq;
                        const f32x4 a = v[bj][0], b = v[bj][1];
                        u32x4 w; w.x = cvtpk(a[0], a[1]); w.y = cvtpk(a[2], a[3]); w.z = cvtpk(b[0], b[1]); w.w = cvtpk(b[2], b[3]);
                        *(u32x4*)(VB + (size_t)row * 512 + col) = w; __builtin_nontemporal_store(a, (f32x4*)(vout + orow * 512 + col)); __builtin_nontemporal_store(b, (f32x4*)(vout + orow * 512 + col + 4));
                    }
                }
            }
    }
};

struct EpiRes {
    static constexpr bool PERM = true;
    const float* res_f; const bf16_t* res_b;
    float* out; bf16_t* outb; float* ssq;
    __device__ __forceinline__ void operator()(const f32x4 (&acc)[2][2][4][2], const Unit& u, int wr, int wc, int fr, int fq) const {
#pragma unroll
        for (int ai = 0; ai < 2; ++ai)
#pragma unroll
        for (int mp = 0; mp < 2; ++mp) {
            f32x4 rv[2][2][2];
            if (res_f) {
#pragma unroll
                for (int mm = 0; mm < 2; ++mm) {
                    const int row = u.pm * BM + ai * HALF + wr * 64 + (2 * mp + mm) * 16 + fr;
                    const float* rp = res_f + (size_t)row * D;
#pragma unroll
                    for (int bj = 0; bj < 2; ++bj) { const int col = u.pn * BM + bj * HALF + wc * 32 + 8 * fq; rv[mm][bj][0] = *(const f32x4*)(rp + col); rv[mm][bj][1] = *(const f32x4*)(rp + col + 4); }
                }
            } else {
                u32x4 rb[2][2];
#pragma unroll
                for (int mm = 0; mm < 2; ++mm) {
                    const int row = u.pm * BM + ai * HALF + wr * 64 + (2 * mp + mm) * 16 + fr;
#pragma unroll
                    for (int bj = 0; bj < 2; ++bj) rb[mm][bj] = *(const u32x4*)(res_b + (size_t)row * D + u.pn * BM + bj * HALF + wc * 32 + 8 * fq);
                }
                __builtin_amdgcn_sched_barrier(0);
#pragma unroll
                for (int mm = 0; mm < 2; ++mm)
#pragma unroll
                    for (int bj = 0; bj < 2; ++bj) { const u32x4 w = rb[mm][bj];
                        rv[mm][bj][0] = (f32x4){bflo(w.x), bfhi(w.x), bflo(w.y), bfhi(w.y)}; rv[mm][bj][1] = (f32x4){bflo(w.z), bfhi(w.z), bflo(w.w), bfhi(w.w)}; }
            }
            __builtin_amdgcn_sched_barrier(0);
#pragma unroll
            for (int mm = 0; mm < 2; ++mm) {
                const int m = 2 * mp + mm;
                const int row = u.pm * BM + ai * HALF + wr * 64 + m * 16 + fr;
                float q = 0.f;
#pragma unroll
                for (int bj = 0; bj < 2; ++bj) {
                    const int col = u.pn * BM + bj * HALF + wc * 32 + 8 * fq;
                    const f32x4 a = acc[ai][bj][m][0] + rv[mm][bj][0], b = acc[ai][bj][m][1] + rv[mm][bj][1];
                    if (out) { __builtin_nontemporal_store(a, (f32x4*)(out + (size_t)row * D + col)); __builtin_nontemporal_store(b, (f32x4*)(out + (size_t)row * D + col + 4)); }
                    if (outb) {
                        u32x4 w; w.x = cvtpk(a[0], a[1]); w.y = cvtpk(a[2], a[3]); w.z = cvtpk(b[0], b[1]); w.w = cvtpk(b[2], b[3]);
                        *(u32x4*)(outb + (size_t)row * D + col) = w;
                        q += (a[0] * a[0] + a[1] * a[1]) + (a[2] * a[2] + a[3] * a[3]) + (b[0] * b[0] + b[1] * b[1]) + (b[2] * b[2] + b[3] * b[3]);
                    }
                }
                if (outb) { q += __shfl_xor(q, 16); q += __shfl_xor(q, 32); if (fq == 0) atomicAdd(ssq + row, q); }
            }
            __builtin_amdgcn_sched_barrier(0);
        }
    }
};

struct EpiUp {
    static constexpr bool PERM = true;
    const float* ssq; bf16_t* U;
    __device__ __forceinline__ void operator()(const f32x4 (&acc)[2][2][4][2], const Unit& u, int wr, int wc, int fr, int fq) const {
        float sv[2][4];
#pragma unroll
        for (int ai = 0; ai < 2; ++ai)
#pragma unroll
            for (int m = 0; m < 4; ++m) sv[ai][m] = ssq[u.pm * BM + ai * HALF + wr * 64 + m * 16 + fr];
        __builtin_amdgcn_sched_barrier(0);
#pragma unroll
        for (int ai = 0; ai < 2; ++ai)
#pragma unroll
            for (int m = 0; m < 4; ++m) {
                const int row = u.pm * BM + ai * HALF + wr * 64 + m * 16 + fr;
                const float s = rsqrtf(sv[ai][m] * (1.0f / D) + EPS);
#pragma unroll
                for (int bj = 0; bj < 2; ++bj) {
                    const int col = u.pn * BM + bj * HALF + wc * 32 + 8 * fq;
                    f32x4 a = acc[ai][bj][m][0] * s, b = acc[ai][bj][m][1] * s;
#pragma unroll
                    for (int i = 0; i < 4; ++i) { const float x = fmaxf(a[i], 0.f), y = fmaxf(b[i], 0.f); a[i] = x * x; b[i] = y * y; }
                    u32x4 w; w.x = cvtpk(a[0], a[1]); w.y = cvtpk(a[2], a[3]); w.z = cvtpk(b[0], b[1]); w.w = cvtpk(b[2], b[3]);
                    *(u32x4*)(U + (size_t)row * FF + col) = w;
                }
            }
    }
};
}

__device__ __forceinline__ int win_src_col(int pb) {
    const int pn = pb >> 3, pc0 = (pb & 7) * 32;
    int logical = pc0;
    if (pn >= 6 && pn <= 9) { const int bj = pc0 >> 7, wc = (pc0 & 127) >> 5; logical = 64 * wc + 32 * bj; }
    const int Lc = 256 * pn + logical;
    return Lc < 1536 ? Lc : Lc + 16;
}
__device__ __forceinline__ void transpose_item(const float* W, int ldw, int src_col0, bool alr, int k0, bf16_t* WT, int K, int dst_row0, const float* g, LAS float* scr, int lane, bool late = false) {
    const int r8 = lane >> 3, c4 = lane & 7, coff = alr ? 4 * (c4 & 3) : 4 * c4;
    f32x4 wv[8]; float gv[8];
#pragma unroll
    for (int u = 0; u < 8; ++u) { const int kk = 8 * u + r8; wv[u] = __builtin_nontemporal_load((const f32x4*)(W + (size_t)(k0 + kk) * ldw + src_col0 + coff)); gv[u] = g ? g[k0 + kk] : 1.0f; }
    __builtin_amdgcn_sched_barrier(0);
#pragma unroll
    for (int u = 0; u < 8; ++u) { const int kk = 8 * u + r8; LAS float* d_ = scr + kk * 33 + 4 * c4;
        d_[0] = wv[u][0] * gv[u]; d_[1] = wv[u][1] * gv[u]; d_[2] = wv[u][2] * gv[u]; d_[3] = wv[u][3] * gv[u]; }
    asm volatile("s_waitcnt lgkmcnt(0)" ::: "memory");
    const int c = lane & 7;
#pragma unroll
    for (int j = 0; j < 4; ++j) { const int n = (lane >> 3) + 8 * j; const LAS float* s = scr + (8 * c) * 33 + n;
        u32x4 o; o.x = cvtpk(s[0 * 33], s[1 * 33]); o.y = cvtpk(s[2 * 33], s[3 * 33]); o.z = cvtpk(s[4 * 33], s[5 * 33]); o.w = cvtpk(s[6 * 33], s[7 * 33]);
        u32x4* dp_ = (u32x4*)(WT + (size_t)(dst_row0 + n) * K + k0 + 8 * c);
        if (late) __builtin_nontemporal_store(o, dp_); else *dp_ = o; }
    asm volatile("s_waitcnt lgkmcnt(0)" ::: "memory");
}

__device__ __forceinline__ void prologue(const Args& a, LAS unsigned char* L, int tid, int wave, int lane) {
    unsigned char* ws = a.ws;
    LAS float* scr = (LAS float*)(L + wave * 16384);
    const int gw = blockIdx.x * 8 + wave, NGW = gridDim.x * 8;
    constexpr int I_IN = 16 * 97, I_OUT = 16 * 32, I_UP = 16 * 128, I_DN = 64 * 32, I_L = I_IN + I_OUT + I_UP + I_DN;
    for (int it = gw; it < 2 * I_L; it += NGW) {
        const int l = it / I_L; int r = it % I_L;
        if (r < I_IN) { const int kb = r / 97, pb = r % 97; const bool alr = pb == 96;
            transpose_item(a.in[6] + (size_t)l * D * 3088, 3088, alr ? 1536 : win_src_col(pb), alr, 64 * kb, (bf16_t*)(ws + WS_WIN) + (size_t)l * NINP * D, D, 32 * pb, a.in[5] + l * D, scr, lane, l == 1); continue; }
        r -= I_IN;
        if (r < I_OUT) { const int kb = r / 32, nb = r % 32;
            transpose_item(a.in[12] + (size_t)l * D * D, D, 32 * nb, false, 64 * kb, (bf16_t*)(ws + WS_WOUT) + (size_t)l * D * D, D, 32 * nb, nullptr, scr, lane, l == 1); continue; }
        r -= I_OUT;
        if (r < I_UP) { const int kb = r / 128, nb = r % 128;
            transpose_item(a.in[14] + (size_t)l * D * FF, FF, 32 * nb, false, 64 * kb, (bf16_t*)(ws + WS_WUP) + (size_t)l * FF * D, D, 32 * nb, a.in[13] + l * D, scr, lane, l == 1); continue; }
        r -= I_UP;
        { const int kb = r / 32, nb = r % 32;
            transpose_item(a.in[15] + (size_t)l * FF * D, D, 32 * nb, false, 64 * kb, (bf16_t*)(ws + WS_WDN) + (size_t)l * D * FF, FF, 32 * nb, nullptr, scr, lane, l == 1); }
    }
    float* ssq = (float*)(ws + WS_SSQ);
    bf16_t* AB = (bf16_t*)(ws + WS_AB);
    for (int m = gw; m < M; m += NGW) {
        const float* xr = (m < MP) ? a.in[0] + (size_t)m * D : a.in[1] + (size_t)(m - MP) * D;
        const f32x4* x4 = (const f32x4*)xr + lane;
        f32x4 v[4]; float s = 0.f;
#pragma unroll
        for (int j = 0; j < 4; ++j) { v[j] = __builtin_nontemporal_load(x4 + 64 * j); s += (v[j].x * v[j].x + v[j].y * v[j].y) + (v[j].z * v[j].z + v[j].w * v[j].w); }
        s = wave_sum(s);
        u32x2* o8 = (u32x2*)(AB + (size_t)m * D) + lane;
#pragma unroll
        for (int j = 0; j < 4; ++j) { u32x2 w; w.x = cvtpk(v[j].x, v[j].y); w.y = cvtpk(v[j].z, v[j].w); o8[64 * j] = w; }
        if (lane == 0) ssq[m] = s;
    }
    for (int i = blockIdx.x * 512 + tid; i < 3 * M; i += gridDim.x * 512) ssq[M + i] = 0.f;
}

template <int KS, bool AF32, class EPI, int NJ = 2>
__device__ __forceinline__ void small_gemm(LAS unsigned char* L, const void* Abase, int K, const bf16_t* Bt, int ncg, const EPI& E, int tid, int nrb = 16) {
    const int lane = tid & 63, wave = __builtin_amdgcn_readfirstlane(tid >> 6), r32 = lane & 31, hi = lane >> 5;
    constexpr int GPW = 8 / KS;
    constexpr int PITCH = 144;
    const int grp = wave / KS, ks = wave % KS;
    const int ntasks = nrb * ncg, per_pass = gridDim.x * GPW, npass = (ntasks + per_pass - 1) / per_pass;
    LAS float* RED = (LAS float*)L; LAS float* SSP = (LAS float*)(L + 114688); LAS float* SSR = (LAS float*)(L + 114688 + 1024);
    LAS unsigned char* SA = L + wave * (3 * 32 * PITCH); LAS unsigned char* SB0 = SA + 32 * PITCH; LAS unsigned char* SB1 = SB0 + 32 * PITCH;
    for (int p = 0; p < npass; ++p) {
        const int task = (p * gridDim.x + blockIdx.x) * GPW + grp;
        const bool act = task < ntasks;
        f32x16 acc0, acc1;
#pragma unroll
        for (int i = 0; i < 16; ++i) { acc0[i] = 0.f; acc1[i] = 0.f; }
        float q8[8];
#pragma unroll
        for (int i = 0; i < 8; ++i) q8[i] = 0.f;
        int rb = 0, cg = 0;
        if (act) {
            rb = task / ncg; cg = task - rb * ncg;
            const int Kw = K / KS, nb = Kw / 64, k0 = ks * Kw;
            const bf16_t* b0p = Bt + (size_t)(E.brow(cg, 0) + (lane >> 3)) * K + k0 + 8 * (lane & 7);
            const bf16_t* b1p = Bt + (size_t)(E.brow(cg, 1) + (lane >> 3)) * K + k0 + 8 * (lane & 7);
            const float* afp = (const float*)Abase + (size_t)(32 * rb + (lane >> 4)) * K + k0 + 4 * (lane & 15);
            const bf16_t* abp = (const bf16_t*)Abase + (size_t)(32 * rb + (lane >> 3)) * K + k0 + 8 * (lane & 7);
            f32x4 xa[8]; u32x4 ab[4], bb0[4], bb1[4];
#define SG_LOAD(kb) do { \
                if constexpr (AF32) { _Pragma("unroll") for (int i = 0; i < 8; ++i) xa[i] = *(const f32x4*)(afp + (size_t)(4 * i) * K + 64 * (kb)); } \
                else { _Pragma("unroll") for (int i = 0; i < 4; ++i) ab[i] = *(const u32x4*)(abp + (size_t)(8 * i) * K + 64 * (kb)); } \
                _Pragma("unroll") for (int i = 0; i < 4; ++i) { bb0[i] = *(const u32x4*)(b0p + (size_t)(8 * i) * K + 64 * (kb)); if constexpr (NJ == 2) bb1[i] = *(const u32x4*)(b1p + (size_t)(8 * i) * K + 64 * (kb)); } } while (0)
            SG_LOAD(0);
            for (int kb = 0; kb < nb; ++kb) {
                __builtin_amdgcn_sched_barrier(0);
                if constexpr (AF32) {
#pragma unroll
                    for (int i = 0; i < 8; ++i) { const f32x4 x = xa[i]; q8[i] += (x[0] * x[0] + x[1] * x[1]) + (x[2] * x[2] + x[3] * x[3]);
                        u32x2 w; w.x = cvtpk(x[0], x[1]); w.y = cvtpk(x[2], x[3]); *(LAS u32x2*)(SA + (4 * i + (lane >> 4)) * PITCH + 8 * (lane & 15)) = w; }
                } else {
#pragma unroll
                    for (int i = 0; i < 4; ++i) *(LAS u32x4*)(SA + (8 * i + (lane >> 3)) * PITCH + 16 * (lane & 7)) = ab[i];
                }
#pragma unroll
                for (int i = 0; i < 4; ++i) { *(LAS u32x4*)(SB0 + (8 * i + (lane >> 3)) * PITCH + 16 * (lane & 7)) = bb0[i]; if constexpr (NJ == 2) *(LAS u32x4*)(SB1 + (8 * i + (lane >> 3)) * PITCH + 16 * (lane & 7)) = bb1[i]; }
                __builtin_amdgcn_sched_barrier(0);
                if (kb + 1 < nb) SG_LOAD(kb + 1);
                __builtin_amdgcn_sched_barrier(0);
#pragma unroll
                for (int j = 0; j < 4; ++j) {
                    const bf16x8 af = *(const LAS bf16x8*)(SA + r32 * PITCH + 32 * j + 16 * hi);
                    const bf16x8 f0 = *(const LAS bf16x8*)(SB0 + r32 * PITCH + 32 * j + 16 * hi);
                    acc0 = MFMA32(af, f0, acc0);
                    if constexpr (NJ == 2) { const bf16x8 f1 = *(const LAS bf16x8*)(SB1 + r32 * PITCH + 32 * j + 16 * hi); acc1 = MFMA32(af, f1, acc1); }
                }
            }
#undef SG_LOAD
        }
        lds_barrier();
        if (ks != 0) {
#pragma unroll
            for (int i = 0; i < 16; ++i) { RED[(wave * 32 + i) * 64 + lane] = acc0[i]; RED[(wave * 32 + 16 + i) * 64 + lane] = acc1[i]; }
        }
        if (AF32) {
#pragma unroll
            for (int i = 0; i < 8; ++i) { float q = q8[i]; q += __shfl_xor(q, 1); q += __shfl_xor(q, 2); q += __shfl_xor(q, 4); q += __shfl_xor(q, 8);
                if ((lane & 15) == 0) SSP[wave * 32 + 4 * i + (lane >> 4)] = q; }
        }
        lds_barrier();
        if (ks == 0 && act) {
#pragma unroll
            for (int w2 = 1; w2 < KS; ++w2)
#pragma unroll
                for (int i = 0; i < 16; ++i) { acc0[i] += RED[((wave + w2) * 32 + i) * 64 + lane]; acc1[i] += RED[((wave + w2) * 32 + 16 + i) * 64 + lane]; }
            float ss[16];
            if (AF32) {
                float t = 0.f;
#pragma unroll
                for (int w2 = 0; w2 < KS; ++w2) t += SSP[(wave + w2) * 32 + r32];
                SSR[grp * 32 + r32] = t;
#pragma unroll
                for (int r = 0; r < 16; ++r) ss[r] = SSR[grp * 32 + crow(r, hi)];
            } else {
#pragma unroll
                for (int r = 0; r < 16; ++r) ss[r] = 0.f;
            }
            E(acc0, acc1, rb, cg, r32, hi, ss);
        }
        lds_barrier();
    }
}

struct SEpiIn {
    int l; unsigned char* ws; float* Ks; float* Vs; const float* qg; const float* kg;
    __device__ __forceinline__ int brow(int cg, int j) const {
        if (cg == 48) return NIN;
        const int pn = cg >> 2, hd = cg & 3;
        if (pn >= 6 && pn <= 9) return 256 * pn + 128 * j + 32 * hd;
        return 64 * cg + 32 * j;
    }
    __device__ __forceinline__ void operator()(const f32x16& acc0, const f32x16& acc1, int rb, int cg, int r32, int hi, const float (&ss)[16]) const {
        const int pn = cg >> 2, hd = cg & 3;
        if (cg == 48) {
            float* ALRP = (float*)(ws + WS_ALRP); float* ssq = (float*)(ws + WS_SSQ) + (size_t)(2 * l) * M;
#pragma unroll
            for (int r = 0; r < 16; ++r) { const int row = MP + 32 * rb + crow(r, hi);
                if (r32 < 16) ALRP[(size_t)row * 16 + r32] = acc0[r];
                if (r32 == 16) ssq[row] = ss[r]; }
            return;
        }
#pragma unroll
        for (int r = 0; r < 16; ++r) {
            const int rs_ = 32 * rb + crow(r, hi), row = MP + rs_;
            const float s = rsqrtf(ss[r] * (1.0f / D) + EPS);
            const float v0 = acc0[r] * s, v1 = acc1[r] * s;
            if (pn < 6) {
                bf16_t* base; int pitch, c0; float sc = 1.f;
                if (pn == 0) { base = (bf16_t*)(ws + WS_GQ); pitch = 256; c0 = 64 * cg; sc = 0.125f; }
                else if (pn == 1) { base = (bf16_t*)(ws + WS_GK); pitch = 256; c0 = 64 * (cg - 4); }
                else if (pn < 4) { base = (bf16_t*)(ws + WS_GV); pitch = 512; c0 = 64 * (cg - 8); }
                else { base = (bf16_t*)(ws + WS_GATE); pitch = 512; c0 = 64 * (cg - 16); }
                base[(size_t)row * pitch + c0 + r32] = (bf16_t)f2bf(v0 * sc); base[(size_t)row * pitch + c0 + 32 + r32] = (bf16_t)f2bf(v1 * sc);
            } else if (pn < 10) {
                float q = v0 * v0 + v1 * v1;
                q += __shfl_xor(q, 1); q += __shfl_xor(q, 2); q += __shfl_xor(q, 4); q += __shfl_xor(q, 8); q += __shfl_xor(q, 16);
                const float rn = rsqrtf(q * (1.0f / 64.0f) + EPS);
                const bool isq = pn < 8;
                const float* gp = isq ? qg : kg;
                const int col = ((pn & 1) * 4 + hd) * 64 + r32;
                const float a0 = v0 * rn * gp[r32], a1 = v1 * rn * gp[32 + r32];
                if (isq) { bf16_t* SQ = (bf16_t*)(ws + WS_SQ); SQ[(size_t)row * 512 + col] = (bf16_t)f2bf(a0 * QSCALE); SQ[(size_t)row * 512 + col + 32] = (bf16_t)f2bf(a1 * QSCALE); }
                else { bf16_t* KB = (bf16_t*)(ws + WS_KB); KB[(size_t)row * 512 + col] = (bf16_t)f2bf(a0); KB[(size_t)row * 512 + col + 32] = (bf16_t)f2bf(a1);
                    Ks[(size_t)rs_ * 512 + col] = a0; Ks[(size_t)rs_ * 512 + col + 32] = a1; }
            } else {
                const int col = 64 * (cg - 40) + r32; bf16_t* VB = (bf16_t*)(ws + WS_VB);
                VB[(size_t)row * 512 + col] = (bf16_t)f2bf(v0); VB[(size_t)row * 512 + col + 32] = (bf16_t)f2bf(v1);
                Vs[(size_t)rs_ * 512 + col] = v0; Vs[(size_t)rs_ * 512 + col + 32] = v1;
            }
        }
    }
};
struct SEpiAlr {
    float* ALRP;
    __device__ __forceinline__ int brow(int cg, int j) const { return NIN; }
    __device__ __forceinline__ void operator()(const f32x16& acc0, const f32x16& acc1, int rb, int cg, int r32, int hi, const float (&ss)[16]) const {
        if (r32 < 16) {
#pragma unroll
            for (int r = 0; r < 16; ++r) ALRP[(size_t)(32 * rb + crow(r, hi)) * 16 + r32] = acc0[r];
        }
    }
};
struct SEpiRes {
    const float* res; float* out;
    __device__ __forceinline__ int brow(int cg, int j) const { return 64 * cg + 32 * j; }
    __device__ __forceinline__ void operator()(const f32x16& acc0, const f32x16& acc1, int rb, int cg, int r32, int hi, const float (&ss)[16]) const {
#pragma unroll
        for (int r = 0; r < 16; ++r) { const size_t o = (size_t)(32 * rb + crow(r, hi)) * D + 64 * cg + r32;
            out[o] = res[o] + acc0[r]; out[o + 32] = res[o + 32] + acc1[r]; }
    }
};
struct SEpiUp {
    bf16_t* U;
    __device__ __forceinline__ int brow(int cg, int j) const { return 64 * cg + 32 * j; }
    __device__ __forceinline__ void operator()(const f32x16& acc0, const f32x16& acc1, int rb, int cg, int r32, int hi, const float (&ss)[16]) const {
#pragma unroll
        for (int r = 0; r < 16; ++r) { const size_t o = (size_t)(32 * rb + crow(r, hi)) * FF + 64 * cg + r32;
            const float s = rsqrtf(ss[r] * (1.0f / D) + EPS); const float x = fmaxf(acc0[r] * s, 0.f), y = fmaxf(acc1[r] * s, 0.f);
            U[o] = (bf16_t)f2bf(x * x); U[o + 32] = (bf16_t)f2bf(y * y); }
    }
};

__device__ __forceinline__ void alr_phase(const Args& a, int l, int wave, int lane) {
    const int r32 = lane & 31, hi = lane >> 5;
    const bf16_t* AB = (const bf16_t*)(a.ws + WS_AB);
    const bf16_t* Wt = (const bf16_t*)(a.ws + WS_WIN) + (size_t)l * NINP * D + (size_t)NIN * D;
    float* ALRP = (float*)(a.ws + WS_ALRP);
    const int NGW = gridDim.x * 8;
    for (int task = blockIdx.x * 8 + wave; task < 512 * 4; task += NGW) {
        const int rb = task >> 2, kq = task & 3;
        const bf16_t* ap = AB + (size_t)(32 * rb + r32) * D + 256 * kq + 8 * hi;
        const bf16_t* bp = Wt + (size_t)r32 * D + 256 * kq + 8 * hi;
        f32x16 acc;
#pragma unroll
        for (int i = 0; i < 16; ++i) acc[i] = 0.f;
#pragma unroll
        for (int kk = 0; kk < 16; ++kk) acc = MFMA32(*(const bf16x8*)(ap + 16 * kk), *(const bf16x8*)(bp + 16 * kk), acc);
        if (r32 < 16) {
#pragma unroll
            for (int r = 0; r < 16; ++r) ALRP[((size_t)kq * M + 32 * rb + crow(r, hi)) * 16 + r32] = acc[r];
        }
    }
}

__device__ __forceinline__ s16x4 vtr(const LAS unsigned char* p) { return __builtin_bit_cast(s16x4, __builtin_amdgcn_ds_read_tr16_b64_v4i16((LAS v4i16_t*)p)); }

template <bool MASK>
__device__ __forceinline__ void sb_ew(f32x16& p, float (&om)[16], int kbase, int qpos) {
#pragma unroll
    for (int r = 0; r < 16; ++r) {
        const float x = __builtin_fmaxf(p[r], -100.0f);
        const float e = __builtin_amdgcn_exp2f(-x), b = __builtin_amdgcn_rcpf(1.0f + e), o_ = e * b;
        if (MASK) { const bool ok = (kbase + (r & 3) + 8 * (r >> 2)) < qpos; om[r] = ok ? o_ : 1.0f; p[r] = ok ? b : 0.0f; }
        else { om[r] = o_; p[r] = b; }
    }
}
__device__ __forceinline__ void sb_cum(f32x16& p, const float (&om)[16], float& run, int hi) {
#pragma unroll
    for (int g = 3; g >= 0; --g) {
        const float Go = (om[4 * g] * om[4 * g + 1]) * (om[4 * g + 2] * om[4 * g + 3]); const float Gp = __shfl_xor(Go, 32);
        const float c3 = run * (hi == 0 ? Gp : 1.0f), c2 = c3 * om[4 * g + 3], c1 = c2 * om[4 * g + 2], c0 = c1 * om[4 * g + 1];
        p[4 * g + 3] *= c3; p[4 * g + 2] *= c2; p[4 * g + 1] *= c1; p[4 * g] *= c0;
        run *= Go * Gp;
    }
}

__device__ __forceinline__ void sb_unit(const Args& a, int l, int u, LAS unsigned char* wl, int lane) {
    const int r32 = lane & 31, hi = lane >> 5;
    const bf16_t* SQ = (const bf16_t*)(a.ws + WS_SQ); const bf16_t* KB = (const bf16_t*)(a.ws + WS_KB); const bf16_t* VB = (const bf16_t*)(a.ws + WS_VB);
    bf16_t* MIX = (bf16_t*)(a.ws + WS_MIX);
    int h, qrow0, q0pos, kbrow0, ncache = 0; const float* kc = nullptr; const float* vc = nullptr;
    if (u < 4096) { const int b = u >> 10, qb = u & 127; h = (u >> 7) & 7; qrow0 = b * 4096 + 32 * qb; q0pos = 32 * qb; kbrow0 = b * 4096; }
    else { const int u2 = u - 4096, b = u2 >> 4, qb = u2 & 1; h = (u2 >> 1) & 7; qrow0 = MP + b * 64 + 32 * qb; q0pos = 1024 + 32 * qb; kbrow0 = MP + b * 64 - 1024; ncache = 16;
        kc = a.in[2] + ((size_t)(l * 8 + b) * 1024) * 512 + h * 64; vc = a.in[3] + ((size_t)(l * 8 + b) * 1024) * 512 + h * 64; }
    bf16x8 qr[4];
#pragma unroll
    for (int d0 = 0; d0 < 4; ++d0) qr[d0] = *(const bf16x8*)(SQ + (size_t)(qrow0 + r32) * 512 + h * 64 + 16 * d0 + 8 * hi);
    f32x16 o[2];
#pragma unroll
    for (int i = 0; i < 16; ++i) { o[0][i] = 0.f; o[1][i] = 0.f; }
    float carry = 1.0f;
    const int qpos = q0pos + r32;
    const LAS unsigned char* vp = wl + ((lane >> 4) & 1) * 32 + (lane & 3) * 8 + (4 * hi + ((lane & 15) >> 2)) * 64;
    const int jt0 = (q0pos + 30) >> 6;
    bf16x8 kf[2][4]; u32x4 vraw[8];
    const bf16_t* kbp = KB + (size_t)(kbrow0 + r32) * 512 + h * 64 + 8 * hi;
    const bf16_t* vbp = VB + (size_t)(kbrow0 + (lane >> 2)) * 512 + h * 64 + 8 * (lane & 3);
#define SB_LOADB(JT) do { const bf16_t* kp_ = kbp + (size_t)(JT) * (64 * 512); const bf16_t* vp_ = vbp + (size_t)(JT) * (64 * 512); \
        _Pragma("unroll") for (int hf = 0; hf < 2; ++hf) _Pragma("unroll") for (int d0 = 0; d0 < 4; ++d0) kf[hf][d0] = *(const bf16x8*)(kp_ + hf * (32 * 512) + 16 * d0); \
        _Pragma("unroll") for (int p = 0; p < 8; ++p) vraw[p] = *(const u32x4*)(vp_ + (16 * (p & 3)) * 512 + 32 * (p >> 2)); } while (0)
    if (jt0 >= ncache) SB_LOADB(jt0);
    for (int jt = jt0; jt >= 0; --jt) {
        if (jt < ncache) {
            const float* kp = kc + (size_t)(64 * jt + r32) * 512 + 8 * hi;
            {
                f32x4 kx[2][4][2];
#pragma unroll
                for (int hf = 0; hf < 2; ++hf)
#pragma unroll
                    for (int d0 = 0; d0 < 4; ++d0) { const float* p = kp + (size_t)hf * 32 * 512 + 16 * d0; kx[hf][d0][0] = *(const f32x4*)p; kx[hf][d0][1] = *(const f32x4*)(p + 4); }
                __builtin_amdgcn_sched_barrier(0);
#pragma unroll
                for (int hf = 0; hf < 2; ++hf)
#pragma unroll
                    for (int d0 = 0; d0 < 4; ++d0) kf[hf][d0] = pack8f(kx[hf][d0][0], kx[hf][d0][1]);
            }
            {
                f32x4 vx[8][2];
#pragma unroll
                for (int p = 0; p < 8; ++p) { const int row = 16 * (p & 3) + (lane >> 2), dc = 32 * (p >> 2) + 8 * (lane & 3);
                    const float* sp = vc + (size_t)(64 * jt + row) * 512 + dc; vx[p][0] = *(const f32x4*)sp; vx[p][1] = *(const f32x4*)(sp + 4); }
                __builtin_amdgcn_sched_barrier(0);
#pragma unroll
                for (int p = 0; p < 8; ++p) vraw[p] = __builtin_bit_cast(u32x4, pack8f(vx[p][0], vx[p][1]));
            }
        }
        __builtin_amdgcn_sched_barrier(0);
        const bool diag = (jt == jt0);
        const bool skip1 = diag && ((q0pos & 63) == 0);
        f32x16 p0, p1;
#pragma unroll
        for (int i = 0; i < 16; ++i) { p0[i] = 0.f; p1[i] = 0.f; }
        if (!skip1) {
#pragma unroll
            for (int d0 = 0; d0 < 4; ++d0) p1 = MFMA32(kf[1][d0], qr[d0], p1);
        }
#pragma unroll
        for (int d0 = 0; d0 < 4; ++d0) p0 = MFMA32(kf[0][d0], qr[d0], p0);
#pragma unroll
        for (int p = 0; p < 8; ++p) *(LAS u32x4*)(wl + p * 1024 + lane * 16) = vraw[p];
        __builtin_amdgcn_sched_barrier(0);
        if (jt >= 1 && jt - 1 >= ncache) SB_LOADB(jt - 1);
        __builtin_amdgcn_sched_barrier(0);
        const int kbase = 64 * jt + 4 * hi;
        float run = carry;
        if (!skip1) {
            float l1[16];
            if (diag) sb_ew<true>(p1, l1, kbase + 32, qpos); else sb_ew<false>(p1, l1, kbase + 32, qpos);
            sb_cum(p1, l1, run, hi);
        }
        {
            float l0[16];
            if (diag) sb_ew<true>(p0, l0, kbase, qpos); else sb_ew<false>(p0, l0, kbase, qpos);
            sb_cum(p0, l0, run, hi);
        }
        carry = run;
        bf16x8 pa[4];
        { u32x4 w;
          w.x = cvtpk(p0[0], p0[1]); w.y = cvtpk(p0[2], p0[3]); w.z = cvtpk(p0[4], p0[5]); w.w = cvtpk(p0[6], p0[7]); pa[0] = __builtin_bit_cast(bf16x8, w);
          w.x = cvtpk(p0[8], p0[9]); w.y = cvtpk(p0[10], p0[11]); w.z = cvtpk(p0[12], p0[13]); w.w = cvtpk(p0[14], p0[15]); pa[1] = __builtin_bit_cast(bf16x8, w);
          w.x = cvtpk(p1[0], p1[1]); w.y = cvtpk(p1[2], p1[3]); w.z = cvtpk(p1[4], p1[5]); w.w = cvtpk(p1[6], p1[7]); pa[2] = __builtin_bit_cast(bf16x8, w);
          w.x = cvtpk(p1[8], p1[9]); w.y = cvtpk(p1[10], p1[11]); w.z = cvtpk(p1[12], p1[13]); w.w = cvtpk(p1[14], p1[15]); pa[3] = __builtin_bit_cast(bf16x8, w); }
        asm volatile("s_waitcnt lgkmcnt(0)" ::: "memory");
#pragma unroll
        for (int d0 = 0; d0 < 2; ++d0)
#pragma unroll
            for (int ks = 0; ks < 2; ++ks) {
                const s16x4 lo = vtr(vp + d0 * 4096 + ks * 1024), hh = vtr(vp + d0 * 4096 + ks * 1024 + 512);
                const bf16x8 vf = (bf16x8){lo[0], lo[1], lo[2], lo[3], hh[0], hh[1], hh[2], hh[3]};
                o[d0] = MFMA32(pa[ks], vf, o[d0]);
            }
        if (!skip1) {
#pragma unroll
            for (int d0 = 0; d0 < 2; ++d0)
#pragma unroll
                for (int ks = 2; ks < 4; ++ks) {
                    const s16x4 lo = vtr(vp + d0 * 4096 + ks * 1024), hh = vtr(vp + d0 * 4096 + ks * 1024 + 512);
                    const bf16x8 vf = (bf16x8){lo[0], lo[1], lo[2], lo[3], hh[0], hh[1], hh[2], hh[3]};
                    o[d0] = MFMA32(pa[ks], vf, o[d0]);
                }
        }
        asm volatile("s_waitcnt lgkmcnt(0)" ::: "memory");
        if (__builtin_amdgcn_ballot_w64(carry >= 1e-37f) == 0ull) break;
    }
#undef SB_LOADB
    LAS bf16_t* stg = (LAS bf16_t*)wl;
#pragma unroll
    for (int r = 0; r < 16; ++r) { const int orow = crow(r, hi);
#pragma unroll
        for (int d0 = 0; d0 < 2; ++d0) stg[orow * 64 + d0 * 32 + r32] = (bf16_t)f2bf(o[d0][r]); }
    asm volatile("s_waitcnt lgkmcnt(0)" ::: "memory");
#pragma unroll
    for (int i = 0; i < 4; ++i) { const int row = i * 8 + (lane >> 3), ch = lane & 7; const u32x4 v = *(const LAS u32x4*)(stg + row * 64 + ch * 8);
        *(u32x4*)(MIX + (size_t)(qrow0 + row) * D + 512 + h * 64 + ch * 8) = v; }
    asm volatile("s_waitcnt lgkmcnt(0)" ::: "memory");
}

constexpr unsigned SB_SPLIT = 2400u;
__device__ __forceinline__ void sb_queue(const Args& a, int l, unsigned* qc, unsigned lo, unsigned hi_, LAS unsigned char* wl, int lane) {
    const int wv = __builtin_amdgcn_readfirstlane((int)(threadIdx.x >> 6));
    const unsigned v = (blockIdx.x + 224u) & 255u;
    for (int k = 0; k < 3; ++k) {
        int u; unsigned p = 0u; bool slow = false;
        if (k == 0) { if (wv == 0 && v < 128u) slow = true; else p = 2048u + v * 8u + (unsigned)wv; }
        else if (k == 1) p = v * 8u + (unsigned)wv;
        else { if (wv != 4 || v >= 128u) break; p = 2048u + v * 8u; }
        if (slow) u = 4096 + (int)v;
        else if (p < 3904u) u = (int)(p / 122u) * 128 + 6 + (int)(p % 122u);
        else { const unsigned x = p - 3904u; u = (int)(x / 6u) * 128 + (int)(x % 6u); }
        sb_unit(a, l, u, wl, lane);
    }
}

constexpr int GL_BM = 0;
constexpr int GL_ALR = 16384;
constexpr int GL_WA = GL_ALR + 4096;
constexpr int GL_BA = GL_WA + 4096;
constexpr int GL_SEG = GL_BA + 256;
constexpr int GL_KDT = 32768;
constexpr int GL_QD = GL_KDT + 9216;
constexpr int GL_VT = GL_QD + 9216;
constexpr int GL_ST = GL_VT + 18432;
constexpr int GL_OL = GL_ST + 18432;
static_assert(GL_OL + 64 * 132 * 4 <= 131072, "gla lds");

__device__ __forceinline__ void gla_b(const Args& a, int l, int row0, int h, LAS unsigned char* L, int tid) {
    LAS float* Bm = (LAS float*)(L + GL_BM); LAS float* SEG = (LAS float*)(L + GL_SEG);
    const float* ALRP = (const float*)(a.ws + WS_ALRP); const float* ssq = (const float*)(a.ws + WS_SSQ) + (size_t)(2 * l) * M;
    const int d = tid & 63, tg = __builtin_amdgcn_readfirstlane(tid >> 6);
    float wa[16];
#pragma unroll
    for (int j = 0; j < 16; ++j) wa[j] = a.in[7][((size_t)l * 16 + j) * 256 + h * 64 + d];
    const float ba = a.in[8][l * 256 + h * 64 + d];
    float bl[8]; float run = 0.f;
#pragma unroll
    for (int i = 0; i < 8; ++i) {
        const int row = row0 + 8 * tg + i;
        const float sc = rsqrtf(ssq[row] * (1.0f / D) + EPS);
        const f32x4 a0 = *(const f32x4*)(ALRP + (size_t)row * 16), a1 = *(const f32x4*)(ALRP + (size_t)row * 16 + 4), a2 = *(const f32x4*)(ALRP + (size_t)row * 16 + 8), a3 = *(const f32x4*)(ALRP + (size_t)row * 16 + 12);
        float x = (a0[0] * wa[0] + a0[1] * wa[1]) + (a0[2] * wa[2] + a0[3] * wa[3]);
        x += (a1[0] * wa[4] + a1[1] * wa[5]) + (a1[2] * wa[6] + a1[3] * wa[7]);
        x += (a2[0] * wa[8] + a2[1] * wa[9]) + (a2[2] * wa[10] + a2[3] * wa[11]);
        x += (a3[0] * wa[12] + a3[1] * wa[13]) + (a3[2] * wa[14] + a3[3] * wa[15]);
        x = x * sc + ba;
        const float ls = fminf(x, 0.f) - __logf(1.0f + __expf(-fabsf(x)));
        run += ls * (1.0f / 16.0f); bl[i] = run;
    }
    SEG[tg * 64 + d] = run;
    lds_barrier();
    float off = 0.f;
#pragma unroll
    for (int g = 0; g < 7; ++g) if (g < tg) off += SEG[g * 64 + d];
#pragma unroll
    for (int i = 0; i < 8; ++i) Bm[(8 * tg + i) * 64 + d] = bl[i] + off;
    lds_barrier();
}

__device__ __forceinline__ void gla_vt(const u32x4 v0, const u32x4 v1, LAS unsigned char* L, int tid) {
    LAS bf16_t* VT = (LAS bf16_t*)(L + GL_VT);
    const int s = tid >> 3, dg = tid & 7;
    const int sx = s ^ (8 * dg);
#pragma unroll
    for (int i = 0; i < 4; ++i) { VT[(16 * dg + 2 * i) * 72 + sx] = (bf16_t)(v0[i] & 0xffffu); VT[(16 * dg + 2 * i + 1) * 72 + sx] = (bf16_t)(v0[i] >> 16);
        VT[(16 * dg + 8 + 2 * i) * 72 + sx] = (bf16_t)(v1[i] & 0xffffu); VT[(16 * dg + 8 + 2 * i + 1) * 72 + sx] = (bf16_t)(v1[i] >> 16); }
}

__device__ __forceinline__ void gla_a_item(const Args& a, int l, int item, LAS unsigned char* L, int tid, int wave, int lane) {
    const int ch = item >> 2, h = item & 3, row0 = ch * 64;
    const u32x4 kr = *(const u32x4*)((const bf16_t*)(a.ws + WS_GK) + (size_t)(row0 + (tid >> 3)) * 256 + h * 64 + 8 * (tid & 7));
    const bf16_t* vp_ = (const bf16_t*)(a.ws + WS_GV) + (size_t)(row0 + (tid >> 3)) * 512 + h * 128 + 16 * (tid & 7);
    const u32x4 pv0 = *(const u32x4*)vp_, pv1 = *(const u32x4*)(vp_ + 8);
    gla_b(a, l, row0, h, L, tid);
    LAS float* Bm = (LAS float*)(L + GL_BM); LAS bf16_t* KDT = (LAS bf16_t*)(L + GL_KDT); LAS bf16_t* VT = (LAS bf16_t*)(L + GL_VT);
    { float* bg = a.out + O_Y + (size_t)item * 4096 + tid * 8; *(f32x4*)bg = *(const LAS f32x4*)(Bm + tid * 8); *(f32x4*)(bg + 4) = *(const LAS f32x4*)(Bm + tid * 8 + 4); }
    {
        const int s = tid >> 3, dg = tid & 7;
#pragma unroll
        for (int i = 0; i < 4; ++i) { const int d = 8 * dg + 2 * i;
            KDT[d * 72 + (s ^ (8 * dg))] = (bf16_t)f2bf(bflo(kr[i]) * __expf(Bm[63 * 64 + d] - Bm[s * 64 + d]));
            KDT[(d + 1) * 72 + (s ^ (8 * dg))] = (bf16_t)f2bf(bfhi(kr[i]) * __expf(Bm[63 * 64 + d + 1] - Bm[s * 64 + d + 1])); }
    }
    gla_vt(pv0, pv1, L, tid);
    lds_barrier();
    {
        const int r32 = lane & 31, hi = lane >> 5, di = wave >> 2, vi = wave & 3;
        f32x16 acc;
#pragma unroll
        for (int i = 0; i < 16; ++i) acc[i] = 0.f;
#pragma unroll
        for (int ks = 0; ks < 4; ++ks) { const int krow = 32 * di + r32, vrow = 32 * vi + r32;
            acc = MFMA32(*(const LAS bf16x8*)(KDT + krow * 72 + ((16 * ks + 8 * hi) ^ (8 * ((krow >> 3) & 7)))), *(const LAS bf16x8*)(VT + vrow * 72 + ((16 * ks + 8 * hi) ^ (8 * ((vrow >> 4) & 7)))), acc); }
        if (item < 1024) {
            bf16_t* U = (bf16_t*)(a.ws + WS_UST) + (size_t)item * 8192;
#pragma unroll
            for (int r = 0; r < 16; ++r) U[(32 * di + crow(r, hi)) * 128 + 32 * vi + r32] = (bf16_t)f2bf(acc[r]);
        } else {
            const float* Sin = a.in[4] + (size_t)(l * 32 + item - 1024) * 8192; float* So = a.out + O_GS + (size_t)(l * 32 + item - 1024) * 8192;
#pragma unroll
            for (int r = 0; r < 16; ++r) { const int d = 32 * di + crow(r, hi), o_ = d * 128 + 32 * vi + r32; So[o_] = __expf(Bm[63 * 64 + d]) * Sin[o_] + acc[r]; }
        }
    }
    if (tid < 64) ((float*)(a.ws + WS_DEC))[item * 64 + tid] = __expf(Bm[63 * 64 + tid]);
    lds_barrier();
}

__device__ __forceinline__ void gla_scan(const Args& a, int l, int tid) {
    unsigned* U = (unsigned*)(a.ws + WS_UST); const float* DEC = (const float*)(a.ws + WS_DEC);
    for (int e = blockIdx.x * 512 + tid; e < 65536; e += gridDim.x * 512) {
        const int bh = e >> 12, idx = e & 4095, d = idx >> 6, b = bh >> 2, h = bh & 3;
        unsigned* up = U + (size_t)(b * 256 + h) * 4096 + idx;
        const float* dp = DEC + (b * 256 + h) * 64 + d;
        float S0 = 0.f, S1 = 0.f;
#pragma unroll
        for (int hf = 0; hf < 2; ++hf) {
            unsigned tv[32]; float dv[32];
#pragma unroll
            for (int i = 0; i < 32; ++i) { tv[i] = up[(size_t)(32 * hf + i) * 16384]; dv[i] = dp[(32 * hf + i) * 256]; }
            __builtin_amdgcn_sched_barrier(0);
#pragma unroll
            for (int i = 0; i < 32; ++i) { up[(size_t)(32 * hf + i) * 16384] = cvtpk(S0, S1); S0 = S0 * dv[i] + bflo(tv[i]); S1 = S1 * dv[i] + bfhi(tv[i]); }
            __builtin_amdgcn_sched_barrier(0);
        }
        *(f32x2*)(a.out + O_GP + (size_t)(l * 16 + bh) * 8192 + 2 * idx) = (f32x2){S0, S1};
    }
}

__device__ __forceinline__ void gla_c_item(const Args& a, int l, int item, LAS unsigned char* L, int tid, int wave, int lane, bool smp = false) {
    const int ch = item >> 2, h = item & 3, row0 = ch * 64;
    LAS float* Bm = (LAS float*)(L + GL_BM); LAS bf16_t* KI = (LAS bf16_t*)(L + GL_KDT); LAS bf16_t* QD = (LAS bf16_t*)(L + GL_QD);
    LAS bf16_t* VT = (LAS bf16_t*)(L + GL_VT); LAS bf16_t* ST = (LAS bf16_t*)(L + GL_ST); LAS float* OL = (LAS float*)(L + GL_OL);
    f32x4 bm0 = {0.f, 0.f, 0.f, 0.f}, bm1 = bm0;
    if (!smp) { const float* bg = (const float*)(a.out + O_Y) + (size_t)item * 4096 + tid * 8; bm0 = *(const f32x4*)bg; bm1 = *(const f32x4*)(bg + 4); }
    const u32x4 kr = *(const u32x4*)((const bf16_t*)(a.ws + WS_GK) + (size_t)(row0 + (tid >> 3)) * 256 + h * 64 + 8 * (tid & 7));
    const u32x4 qr = *(const u32x4*)((const bf16_t*)(a.ws + WS_GQ) + (size_t)(row0 + (tid >> 3)) * 256 + h * 64 + 8 * (tid & 7));
    const bf16_t* Sg = (const bf16_t*)(a.ws + WS_UST) + (size_t)item * 8192 + (tid >> 3) * 128 + 16 * (tid & 7);
    u32x4 sg0, sg1;
    if (!smp) { sg0 = *(const u32x4*)Sg; sg1 = *(const u32x4*)(Sg + 8); }
    else {
        const float* Sf = a.in[4] + (size_t)(l * 32 + item - 1024) * 8192 + (tid >> 3) * 128 + 16 * (tid & 7);
        const f32x4 f0 = *(const f32x4*)Sf, f1 = *(const f32x4*)(Sf + 4), f2 = *(const f32x4*)(Sf + 8), f3 = *(const f32x4*)(Sf + 12);
        sg0 = (u32x4){cvtpk(f0[0], f0[1]), cvtpk(f0[2], f0[3]), cvtpk(f1[0], f1[1]), cvtpk(f1[2], f1[3])};
        sg1 = (u32x4){cvtpk(f2[0], f2[1]), cvtpk(f2[2], f2[3]), cvtpk(f3[0], f3[1]), cvtpk(f3[2], f3[3])};
    }
    const bf16_t* vp_ = (const bf16_t*)(a.ws + WS_GV) + (size_t)(row0 + (tid >> 3)) * 512 + h * 128 + 16 * (tid & 7);
    const u32x4 pv0 = *(const u32x4*)vp_, pv1 = *(const u32x4*)(vp_ + 8);
    const bf16_t* gp = (const bf16_t*)(a.ws + WS_GATE) + (size_t)(row0 + (tid >> 3)) * 512 + h * 128 + 16 * (tid & 7);
    const u32x4 g0 = *(const u32x4*)gp, g1 = *(const u32x4*)(gp + 8);
    __builtin_amdgcn_sched_barrier(0);
    if (!smp) { *(LAS f32x4*)(Bm + tid * 8) = bm0; *(LAS f32x4*)(Bm + tid * 8 + 4) = bm1; lds_barrier(); }
    else gla_b(a, l, row0, h, L, tid);
    {
        const int s = tid >> 3, dg = tid & 7;
        u32x4 ko, qo;
#pragma unroll
        for (int i = 0; i < 4; ++i) { const int d = 8 * dg + 2 * i; const float b0 = Bm[s * 64 + d], b1 = Bm[s * 64 + d + 1];
            ko[i] = cvtpk(bflo(kr[i]) * __expf(-b0), bfhi(kr[i]) * __expf(-b1)); qo[i] = cvtpk(bflo(qr[i]) * __expf(b0), bfhi(qr[i]) * __expf(b1)); }
        *(LAS u32x4*)(KI + s * 72 + 8 * dg) = ko; *(LAS u32x4*)(QD + s * 72 + 8 * dg) = qo;
#pragma unroll
        for (int j = 0; j < 4; ++j) { const unsigned w0 = j < 2 ? sg0[2 * j] : sg1[2 * j - 4], w1 = j < 2 ? sg0[2 * j + 1] : sg1[2 * j - 3];
            ST[(16 * dg + 4 * j) * 72 + (s ^ (8 * dg))] = (bf16_t)(w0 & 0xffffu); ST[(16 * dg + 4 * j + 1) * 72 + (s ^ (8 * dg))] = (bf16_t)(w0 >> 16);
            ST[(16 * dg + 4 * j + 2) * 72 + (s ^ (8 * dg))] = (bf16_t)(w1 & 0xffffu); ST[(16 * dg + 4 * j + 3) * 72 + (s ^ (8 * dg))] = (bf16_t)(w1 >> 16); }
    }
    gla_vt(pv0, pv1, L, tid);
    lds_barrier();
    {
        const int r32 = lane & 31, hi = lane >> 5, ti = wave >> 2, vi = wave & 3;
        bf16x8 qf[4];
#pragma unroll
        for (int kd = 0; kd < 4; ++kd) qf[kd] = *(const LAS bf16x8*)(QD + (32 * ti + r32) * 72 + 16 * kd + 8 * hi);
        f32x16 o;
#pragma unroll
        for (int i = 0; i < 16; ++i) o[i] = 0.f;
#pragma unroll
        for (int kd = 0; kd < 4; ++kd) { const int srow = 32 * vi + r32; o = MFMA32(qf[kd], *(const LAS bf16x8*)(ST + srow * 72 + ((16 * kd + 8 * hi) ^ (8 * ((srow >> 4) & 7)))), o); }
        const int tcol = 32 * ti + r32;
#pragma unroll
        for (int sb = 0; sb < 2; ++sb) {
            if (sb <= ti) {
                f32x16 sc;
#pragma unroll
                for (int i = 0; i < 16; ++i) sc[i] = 0.f;
#pragma unroll
                for (int kd = 0; kd < 4; ++kd) sc = MFMA32(*(const LAS bf16x8*)(KI + (32 * sb + r32) * 72 + 16 * kd + 8 * hi), qf[kd], sc);
#pragma unroll
                for (int r = 0; r < 16; ++r) { const int srow = 32 * sb + crow(r, hi); if (srow > tcol) sc[r] = 0.f; }
#pragma unroll
                for (int kq = 0; kq < 2; ++kq) {
                    u32x4 w; w.x = cvtpk(sc[8 * kq], sc[8 * kq + 1]); w.y = cvtpk(sc[8 * kq + 2], sc[8 * kq + 3]); w.z = cvtpk(sc[8 * kq + 4], sc[8 * kq + 5]); w.w = cvtpk(sc[8 * kq + 6], sc[8 * kq + 7]);
                    const int ks = 2 * sb + kq;
                    const int vrow = 32 * vi + r32, vsw = 8 * ((vrow >> 4) & 7);
                    const s16x4 lo = *(const LAS s16x4*)(VT + vrow * 72 + ((16 * ks + 4 * hi) ^ vsw)), hh = *(const LAS s16x4*)(VT + vrow * 72 + ((16 * ks + 8 + 4 * hi) ^ vsw));
                    const bf16x8 vf = (bf16x8){lo[0], lo[1], lo[2], lo[3], hh[0], hh[1], hh[2], hh[3]};
                    o = MFMA32(__builtin_bit_cast(bf16x8, w), vf, o);
                }
            }
        }
#pragma unroll
        for (int r = 0; r < 16; ++r) OL[(32 * ti + crow(r, hi)) * 132 + 32 * vi + r32] = o[r];
    }
    lds_barrier();
    {
        const int t = tid >> 3, sg = tid & 7;
        float x[16]; float q = 0.f;
#pragma unroll
        for (int j = 0; j < 4; ++j) { const f32x4 v = *(const LAS f32x4*)(OL + t * 132 + 16 * sg + 4 * j); x[4 * j] = v[0]; x[4 * j + 1] = v[1]; x[4 * j + 2] = v[2]; x[4 * j + 3] = v[3]; q += (v[0] * v[0] + v[1] * v[1]) + (v[2] * v[2] + v[3] * v[3]); }
        q += __shfl_xor(q, 1); q += __shfl_xor(q, 2); q += __shfl_xor(q, 4);
        const float rs = rsqrtf(q * (1.0f / 128.0f) + EPS);
        const float* ng = a.in[11] + l * 128 + 16 * sg;
        float gt[16];
#pragma unroll
        for (int i = 0; i < 4; ++i) { gt[2 * i] = bflo(g0[i]); gt[2 * i + 1] = bfhi(g0[i]); gt[8 + 2 * i] = bflo(g1[i]); gt[8 + 2 * i + 1] = bfhi(g1[i]); }
        float y[16];
#pragma unroll
        for (int i = 0; i < 16; ++i) { const float gv = gt[i]; const float sl = gv / (1.0f + __expf(-gv)); y[i] = x[i] * rs * ng[i] * sl; }
        u32x4 w0, w1;
#pragma unroll
        for (int i = 0; i < 4; ++i) { w0[i] = cvtpk(y[2 * i], y[2 * i + 1]); w1[i] = cvtpk(y[8 + 2 * i], y[8 + 2 * i + 1]); }
        bf16_t* mp = (bf16_t*)(a.ws + WS_MIX) + (size_t)(row0 + t) * D + h * 128 + 16 * sg;
        *(u32x4*)mp = w0; *(u32x4*)(mp + 8) = w1;
    }
    lds_barrier();
}

#define XB_TMO      128
#define XB_XCNT(j)  (256  + 64 * (j))
#define XB_XSUB(j)  (1280 + 64 * (j))
#define XB_XGEN(j)  (2304 + 64 * (j))
#define XB_TOP      3328
#define XB_TOPGEN   3392
#define XCD_BAR_WORDS 3456
#define XB_SPIN_CAP (1u << 22)
__device__ __forceinline__ unsigned xb_ld(unsigned* p)              { return __hip_atomic_load(p, __ATOMIC_RELAXED, __HIP_MEMORY_SCOPE_AGENT); }
__device__ __forceinline__ unsigned xb_add(unsigned* p, unsigned v) { return __hip_atomic_fetch_add(p, v, __ATOMIC_RELAXED, __HIP_MEMORY_SCOPE_AGENT); }
__device__ __forceinline__ unsigned xb_xcc_id() { return (unsigned)__builtin_amdgcn_s_getreg((3 << 11) | 20) & 0xFu; }
#define XB_SPIN(cond, bar) do { unsigned _sp = 0; while (cond) { __builtin_amdgcn_s_sleep(1); \
    if ((++_sp & 255u) == 0u) { if (xb_ld(&(bar)[XB_TMO])) break; if (_sp > XB_SPIN_CAP) { atomicAdd(&(bar)[XB_TMO], 1u); break; } } } } while (0)
struct XcdBarrier { unsigned* bar; unsigned x; volatile LAS unsigned* st; };
__device__ __forceinline__ XcdBarrier xcd_barrier_post(unsigned* bar, volatile LAS unsigned* st) {
    XcdBarrier b; b.bar = bar; b.x = xb_xcc_id(); b.st = st;
    if (threadIdx.x == 0) (void)xb_add(&bar[XB_XCNT(b.x)], 1u);
    return b;
}
__device__ __forceinline__ void xcd_barrier_complete(unsigned* bar, unsigned x, unsigned& nloc, unsigned& nx) {
    const unsigned G = gridDim.x * gridDim.y * gridDim.z;
    unsigned sum, cnt, mine, sp = 0u;
    for (;;) {
        sum = 0u; cnt = 0u; mine = 0u;
#pragma unroll
        for (unsigned j = 0; j < 16; ++j) { const unsigned c = xb_ld(&bar[XB_XCNT(j)]); sum += c; cnt += (c > 0u) ? 1u : 0u; mine = (j == x) ? c : mine; }
        if (sum == G) break;
        __builtin_amdgcn_s_sleep(1);
        if ((++sp & 255u) == 0u) { if (xb_ld(&bar[XB_TMO])) break; if (sp > XB_SPIN_CAP) { atomicAdd(&bar[XB_TMO], 1u); break; } }
    }
    nloc = mine > 0u ? mine : 1u; nx = cnt > 0u ? cnt : 1u;
}
__device__ __forceinline__ void xcd_barrier(const XcdBarrier& b) {
    asm volatile("s_waitcnt vmcnt(0)" ::: "memory");
    __syncthreads();
    if (threadIdx.x == 0) {
        unsigned* bar = b.bar;
        __builtin_amdgcn_s_waitcnt(0);
        unsigned nloc = b.st[0], nx = b.st[1];
        if (nloc == 0u) { xcd_barrier_complete(bar, b.x, nloc, nx); b.st[0] = nloc; b.st[1] = nx; }
        const unsigned old = xb_add(&bar[XB_XSUB(b.x)], 1u);
        const unsigned gen = old / nloc;
        if (old + 1u == (gen + 1u) * nloc) {
            __builtin_amdgcn_fence(__ATOMIC_RELEASE, "agent");
            asm volatile("s_waitcnt vmcnt(0)" ::: "memory");
            const unsigned og = xb_add(&bar[XB_TOP], 1u);
            const unsigned tg = og / nx;
            if (og + 1u == (tg + 1u) * nx) xb_add(&bar[XB_TOPGEN], 1u);
            else XB_SPIN(xb_ld(&bar[XB_TOPGEN]) == tg, bar);
            __builtin_amdgcn_fence(__ATOMIC_ACQUIRE, "agent");
            xb_add(&bar[XB_XGEN(b.x)], 1u);
            asm volatile("s_waitcnt vmcnt(0)" ::: "memory");
        } else {
            XB_SPIN(xb_ld(&bar[XB_XGEN(b.x)]) == gen, bar);
            __builtin_amdgcn_fence(__ATOMIC_ACQUIRE, "agent");
            asm volatile("s_waitcnt vmcnt(0)" ::: "memory");
        }
    }
    __syncthreads();
}

__device__ __forceinline__ int fresh_tid() { int t = threadIdx.x; asm volatile("" : "+v"(t)); return t; }
#define FRESH() const int tid = fresh_tid(), lane = tid & 63, wave = __builtin_amdgcn_readfirstlane(tid >> 6)
__global__ void __launch_bounds__(512, 2) fwd_kernel(Args a) {
    extern __shared__ __attribute__((aligned(16))) unsigned char lds_raw[];
    cg::grid_group grid = cg::this_grid();
    LAS unsigned char* L = (LAS unsigned char*)lds_raw;
    const int G = gridDim.x;
    unsigned char* ws = a.ws;
    if (a.out == nullptr) grid.sync();
    if (threadIdx.x < 16) ((LAS unsigned*)(L + 131072))[threadIdx.x] = 0u;
    __syncthreads();
    (void)xcd_barrier_post((unsigned*)ws, (volatile LAS unsigned*)(L + 131072));
#define GRID_BAR() do { XcdBarrier b_; b_.bar = (unsigned*)a.ws; b_.x = xb_xcc_id(); b_.st = (volatile LAS unsigned*)(L + 131072); xcd_barrier(b_); } while (0)

    for (int rep = 0; rep < REP_PRO; ++rep) { FRESH(); prologue(a, L, tid, wave, lane); }
    GRID_BAR();

#pragma nounroll
    for (int l = 0; l < 2; ++l) {
        float* ssq = (float*)(ws + WS_SSQ);
        bf16_t* AB = (bf16_t*)(ws + WS_AB);
        for (int rep = 0; rep < REP_SMALL; ++rep) {
        { SEpiAlr EA{(float*)(ws + WS_ALRP)}; small_gemm<4, false, SEpiAlr, 1>(L, (const void*)AB, D, (const bf16_t*)(ws + WS_WIN) + (size_t)l * NINP * D, 1, EA, fresh_tid(), 512); }
        { SEpiIn E{l, ws, a.out + O_KS + (size_t)l * MS * 512, a.out + O_VS + (size_t)l * MS * 512, a.in[9] + l * 64, a.in[10] + l * 64};
          small_gemm<2, true, SEpiIn>(L, l == 0 ? (const void*)a.in[1] : (const void*)(a.out + O_Y + (size_t)MP * D), D, (const bf16_t*)(ws + WS_WIN) + (size_t)l * NINP * D, 49, E, fresh_tid()); }
        }
        {
            pg8::Gemm g{AB, (const bf16_t*)(ws + WS_WIN) + (size_t)l * NINP * D, M, NIN, D};
            pg8::StaticOrder S; S.init(MP, NIN, G, (int)blockIdx.x);
            pg8::EpiIn E{ssq + (size_t)(2 * l) * M, (bf16_t*)(ws + WS_GQ), (bf16_t*)(ws + WS_GK), (bf16_t*)(ws + WS_GV), (bf16_t*)(ws + WS_GATE), (bf16_t*)(ws + WS_SQ), (bf16_t*)(ws + WS_KB), (bf16_t*)(ws + WS_VB),
                          a.out + O_KP + (size_t)l * MP * 512, a.out + O_VP + (size_t)l * MP * 512, a.out + O_KS + (size_t)l * MS * 512, a.out + O_VS + (size_t)l * MS * 512, a.in[9] + l * 64, a.in[10] + l * 64};
            for (int rep = 0; rep < REP_GEMM; ++rep) pg8::gemm_phase<pg8::EpiIn, pg8::StaticOrder, true, true>(L, g, S, E, fresh_tid());
        }
        GRID_BAR();
        { FRESH(); (void)tid; sb_queue(a, l, (unsigned*)ws + 4096 + 64 * (2 * l), 0u, 4224u, L + wave * 8192, lane); }
        __syncthreads();
        { FRESH(); for (int it = blockIdx.x; it < 1024; it += G) gla_a_item(a, l, it, L, tid, wave, lane); }
        GRID_BAR();
        { FRESH(); gla_scan(a, l, tid);
          if (blockIdx.x >= 128 && blockIdx.x < 160) gla_a_item(a, l, 1024 + (int)blockIdx.x - 128, L, tid, wave, lane);
          else if (blockIdx.x >= 160 && blockIdx.x < 192) gla_c_item(a, l, 1024 + (int)blockIdx.x - 160, L, tid, wave, lane, true); }
        GRID_BAR();
        { FRESH(); for (int it = blockIdx.x; it < 1024; it += G) gla_c_item(a, l, it, L, tid, wave, lane); }
        GRID_BAR();
        {
            pg8::Gemm g{(const bf16_t*)(ws + WS_MIX), (const bf16_t*)(ws + WS_WOUT) + (size_t)l * D * D, M, D, D};
            { SEpiRes E2{l == 0 ? a.in[1] : a.out + O_Y + (size_t)MP * D, a.out + O_Y + (size_t)MP * D};
              small_gemm<8, false, SEpiRes>(L, (const void*)((const bf16_t*)(ws + WS_MIX) + (size_t)MP * D), D, (const bf16_t*)(ws + WS_WOUT) + (size_t)l * D * D, 16, E2, fresh_tid()); }
            pg8::StaticOrder S; S.init(MP, D, G, (int)blockIdx.x);
            pg8::EpiRes E{l == 0 ? a.in[0] : (const float*)nullptr, AB, (float*)nullptr, AB, ssq + (size_t)(2 * l + 1) * M};
            pg8::gemm_phase<pg8::EpiRes, pg8::StaticOrder, true, true>(L, g, S, E, fresh_tid());
        }
        GRID_BAR();
        {
            pg8::Gemm g{AB, (const bf16_t*)(ws + WS_WUP) + (size_t)l * FF * D, M, FF, D};
            for (int rep = 0; rep < REP_SMALL; ++rep) { SEpiUp E2{(bf16_t*)(ws + WS_U) + (size_t)MP * FF};
              small_gemm<2, true, SEpiUp>(L, (const void*)(a.out + O_Y + (size_t)MP * D), D, (const bf16_t*)(ws + WS_WUP) + (size_t)l * FF * D, 64, E2, fresh_tid()); }
            pg8::StaticOrder S; S.init(MP, FF, G, (int)blockIdx.x);
            pg8::EpiUp E{ssq + (size_t)(2 * l + 1) * M, (bf16_t*)(ws + WS_U)};
            for (int rep = 0; rep < REP_GEMM; ++rep) pg8::gemm_phase<pg8::EpiUp, pg8::StaticOrder, true, true>(L, g, S, E, fresh_tid());
        }
        GRID_BAR();
        {
            pg8::Gemm g{(const bf16_t*)(ws + WS_U), (const bf16_t*)(ws + WS_WDN) + (size_t)l * D * FF, M, D, FF};
            { SEpiRes E2{a.out + O_Y + (size_t)MP * D, a.out + O_Y + (size_t)MP * D};
              small_gemm<8, false, SEpiRes>(L, (const void*)((const bf16_t*)(ws + WS_U) + (size_t)MP * FF), FF, (const bf16_t*)(ws + WS_WDN) + (size_t)l * D * FF, 16, E2, fresh_tid()); }
            pg8::StaticOrder S; S.init(MP, D, G, (int)blockIdx.x);
            pg8::EpiRes E{(const float*)nullptr, AB, l == 0 ? (float*)nullptr : a.out + O_Y, l == 0 ? AB : (bf16_t*)nullptr, ssq + (size_t)(l == 0 ? 2 : 3) * M};
            pg8::gemm_phase<pg8::EpiRes, pg8::StaticOrder, true, true>(L, g, S, E, fresh_tid());
        }
        if (l == 0) GRID_BAR();
    }
}

extern "C" void kernel_launch(void* const* d_in, const int* in_sizes, int n_in, void* d_out, int out_size, void* d_ws, size_t ws_size, hipStream_t stream) {
    static int grid = 0;
    if (grid == 0) {
        if (n_in != 16 || (size_t)out_size != O_END || ws_size < WS_END) { fprintf(stderr, "kernel_launch: unexpected shapes (n_in %d out %d ws %zu)\n", n_in, out_size, ws_size); grid = -1; return; }
        int dev = 0, cus = 0, per_cu = 0;
        (void)hipGetDevice(&dev);
        (void)hipDeviceGetAttribute(&cus, hipDeviceAttributeMultiprocessorCount, dev);
        if (hipFuncSetAttribute((const void*)fwd_kernel, hipFuncAttributeMaxDynamicSharedMemorySize, LDS_BYTES) != hipSuccess) { fprintf(stderr, "kernel_launch: hipFuncSetAttribute failed\n"); grid = -1; return; }
        (void)hipOccupancyMaxActiveBlocksPerMultiprocessor(&per_cu, (const void*)fwd_kernel, 512, LDS_BYTES);
        (void)hipGetLastError();
        grid = cus > 0 ? cus : 256;
        if (per_cu < 1) fprintf(stderr, "kernel_launch: occupancy query says %d blocks per CU\n", per_cu);
    }
    if (grid < 0) return;
    if (hipMemsetAsync(d_ws, 0, 32768, stream) != hipSuccess) { fprintf(stderr, "kernel_launch: memset failed\n"); return; }
    Args a{};
    for (int i = 0; i < 16; ++i) a.in[i] = (const float*)d_in[i];
    a.out = (float*)d_out; a.ws = (unsigned char*)d_ws;
    void* args[] = {&a};
    hipError_t e = hipLaunchCooperativeKernel((const void*)fwd_kernel, dim3(grid), dim3(512), args, LDS_BYTES, stream);
    if (e != hipSuccess) fprintf(stderr, "kernel_launch: cooperative launch failed: %s (grid %d)\n", hipGetErrorString(e), grid);
}
```
